# Optimizing an MI355X kernel written in HIP

```python
import math
import jax, jax.numpy as jnp
from jax import lax
import numpy as np

D_MODEL = 2048
BATCH = 4
SEQ = 2048
DEPTH = 1
DEC_BATCH = 128
DEC_SEQ = 8
PAST_LEN = 16384
PAGE_SIZE = 128

EXPAND = 2
D_MIX = EXPAND * D_MODEL
D_SSM = D_MIX // 2
D_SHORT = D_MIX - D_SSM
SSD_HEAD_DIM = 64
SSD_HEADS = D_SSM // SSD_HEAD_DIM
SSD_D_STATE = 128
SSD_GROUPS = 4
SSD_HPG = SSD_HEADS // SSD_GROUPS
SSD_GN = SSD_GROUPS * SSD_D_STATE
SSD_CONV_DIM = D_SSM + 2 * SSD_GN
SSD_CONV_K = 4
SSD_CHUNK = 128
SHORT_CONV_K = 3
SHORT_CHANNEL_GROUPS = 32
EPS = 1e-6
D_IN_PROJ = D_SSM + SSD_CONV_DIM + SSD_HEADS + 4 * D_SHORT
SPLIT_POINTS = (D_SSM,
                D_SSM + SSD_CONV_DIM,
                D_SSM + SSD_CONV_DIM + SSD_HEADS,
                D_SSM + SSD_CONV_DIM + SSD_HEADS + D_SHORT,
                D_SSM + SSD_CONV_DIM + SSD_HEADS + 2 * D_SHORT,
                D_SSM + SSD_CONV_DIM + SSD_HEADS + 3 * D_SHORT)

kernel_name = "hymba_ssd_shortconv_decode_step"


def rmsnorm(x, w):
    xf = x.astype(jnp.float32)
    var = jnp.mean(xf * xf, axis=-1, keepdims=True)
    return (xf * lax.rsqrt(var + EPS) * w.astype(jnp.float32)).astype(x.dtype)


def grouped_rmsnorm(y, w, groups):
    b, L, d = y.shape
    yf = y.astype(jnp.float32).reshape(b, L, groups, d // groups)
    yf = yf * lax.rsqrt(jnp.mean(yf * yf, axis=-1, keepdims=True) + EPS)
    return (yf.reshape(b, L, d) * w.astype(jnp.float32)).astype(y.dtype)


def causal_dwconv(u, prev, w):
    k = w.shape[0]
    L = u.shape[1]
    full = jnp.concatenate([prev.astype(u.dtype), u], axis=1)
    out = full[:, 0:L] * w[0]
    for i in range(1, k):
        out = out + full[:, i:i + L] * w[i]
    return out, full[:, L:]


def ssd_scan(x, dt, a, bmat, cmat, d_skip, h0):
    bsz, L = x.shape[0], x.shape[1]
    chunk = min(SSD_CHUNK, L)
    pad = (-L) % chunk
    xf = x.astype(jnp.float32)
    bf = bmat.astype(jnp.float32)
    cf = cmat.astype(jnp.float32)
    dtf = dt
    if pad:
        pw = ((0, 0), (0, pad))
        xf_p = jnp.pad(xf, pw + ((0, 0), (0, 0)))
        bf = jnp.pad(bf, pw + ((0, 0), (0, 0)))
        cf = jnp.pad(cf, pw + ((0, 0), (0, 0)))
        dtf = jnp.pad(dtf, pw + ((0, 0),))
    else:
        xf_p = xf
    nc = (L + pad) // chunk
    xdt = (xf_p * dtf[..., None]).reshape(bsz, nc, chunk, SSD_GROUPS, SSD_HPG, SSD_HEAD_DIM)
    la = (dtf * a.astype(jnp.float32)).reshape(bsz, nc, chunk, SSD_GROUPS, SSD_HPG)
    bc = bf.reshape(bsz, nc, chunk, SSD_GROUPS, SSD_D_STATE)
    cc = cf.reshape(bsz, nc, chunk, SSD_GROUPS, SSD_D_STATE)
    a_cum = jnp.cumsum(la, axis=2)
    seg = a_cum[:, :, :, None] - a_cum[:, :, None, :]
    causal = jnp.tril(jnp.ones((chunk, chunk), dtype=bool))[:, :, None, None]
    decay = jnp.exp(jnp.where(causal, seg, -jnp.inf))
    cb = jnp.einsum('bclgn,bcsgn->bclsg', cc, bc)
    y_diag = jnp.einsum('bclsg,bclsgh,bcsghp->bclghp', cb, decay, xdt)
    decay_end = jnp.exp(a_cum[:, :, -1:] - a_cum)
    states = jnp.einsum('bclgn,bclgh,bclghp->bcghpn', bc, decay_end, xdt)
    chunk_decay = jnp.exp(a_cum[:, :, -1])

    def step(h, inp):
        s, dcy = inp
        h_next = h * dcy[..., None, None] + s
        return h_next, h

    h_init = h0.astype(jnp.float32).reshape(bsz, SSD_GROUPS, SSD_HPG, SSD_HEAD_DIM, SSD_D_STATE)
    h_fin, h_prev = lax.scan(step, h_init,
                             (jnp.moveaxis(states, 1, 0), jnp.moveaxis(chunk_decay, 1, 0)))
    h_prev = jnp.moveaxis(h_prev, 0, 1)
    y_off = jnp.einsum('bclgn,bcghpn,bclgh->bclghp', cc, h_prev, jnp.exp(a_cum))
    y = (y_diag + y_off).reshape(bsz, nc * chunk, SSD_HEADS, SSD_HEAD_DIM)[:, :L]
    y = y + xf * d_skip.astype(jnp.float32)[:, None]
    return y.astype(x.dtype), h_fin.reshape(bsz, SSD_HEADS, SSD_HEAD_DIM, SSD_D_STATE)


def mixer_layer(x, h_ssm, buf_ssd, buf_short, norm_w, w_in, conv_ssd_w, conv_ssd_b,
                dt_bias, a_log, d_skip, ssd_norm_w, conv_short_w, w_out):
    bsz, L, _ = x.shape
    h = rmsnorm(x, norm_w)
    proj = jnp.einsum('bld,de->ble', h, w_in)
    z_s, xbc, dt_raw, z_c, b_c, c_c, v_c = jnp.split(proj, SPLIT_POINTS, axis=-1)
    xbc, buf_ssd_new = causal_dwconv(xbc, buf_ssd, conv_ssd_w)
    xbc = jax.nn.silu(xbc + conv_ssd_b)
    xs, bm, cm = jnp.split(xbc, (D_SSM, D_SSM + SSD_GN), axis=-1)
    xs = xs.reshape(bsz, L, SSD_HEADS, SSD_HEAD_DIM)
    bm = bm.reshape(bsz, L, SSD_GROUPS, SSD_D_STATE)
    cm = cm.reshape(bsz, L, SSD_GROUPS, SSD_D_STATE)
    dt = jax.nn.softplus(dt_raw.astype(jnp.float32) + dt_bias.astype(jnp.float32))
    a = -jnp.exp(a_log.astype(jnp.float32))
    y_s, h_new = ssd_scan(xs, dt, a, bm, cm, d_skip, h_ssm)
    y_s = grouped_rmsnorm(y_s.reshape(bsz, L, D_SSM) * jax.nn.silu(z_s), ssd_norm_w, SSD_GROUPS)
    conv_out, buf_short_new = causal_dwconv(c_c * v_c, buf_short, conv_short_w)
    y_c = b_c * conv_out * jax.nn.silu(z_c)
    y = jnp.einsum('ble,ed->bld', jnp.concatenate([y_s, y_c], axis=-1), w_out)
    return x + y, h_new.astype(x.dtype), buf_ssd_new, buf_short_new


def setup_inputs(seed: int = 0) -> dict:
    key = jax.random.key(seed)
    ks = jax.random.split(key, 20)
    f32 = jnp.float32
    x_prompt = jax.random.normal(ks[0], (BATCH, SEQ, D_MODEL), f32)
    x_sample = jax.random.normal(ks[1], (DEC_BATCH, DEC_SEQ, D_MODEL), f32)
    state_ssm = 0.1 * jax.random.normal(ks[2], (DEPTH, DEC_BATCH, SSD_HEADS, SSD_HEAD_DIM, SSD_D_STATE), f32)
    state_conv_ssd = jax.random.normal(ks[3], (DEPTH, DEC_BATCH, SSD_CONV_K - 1, SSD_CONV_DIM), f32)
    state_conv_short = jax.random.normal(ks[4], (DEPTH, DEC_BATCH, SHORT_CONV_K - 1, D_SHORT), f32)
    norm_w = 1.0 + 0.02 * jax.random.normal(ks[5], (DEPTH, D_MODEL), f32)
    w_in = jax.random.normal(ks[6], (DEPTH, D_MODEL, D_IN_PROJ), f32) * D_MODEL ** -0.5
    conv_ssd_w = jax.random.normal(ks[7], (DEPTH, SSD_CONV_K, SSD_CONV_DIM), f32) * SSD_CONV_K ** -0.5
    conv_ssd_b = 0.02 * jax.random.normal(ks[8], (DEPTH, SSD_CONV_DIM), f32)
    dt0 = jnp.exp(jax.random.uniform(ks[9], (DEPTH, SSD_HEADS), f32,
                                     math.log(1e-3), math.log(1e-1)))
    dt_bias = dt0 + jnp.log(-jnp.expm1(-dt0))
    a_log = jnp.log(jax.random.uniform(ks[10], (DEPTH, SSD_HEADS), f32, 1.0, 16.0))
    d_skip = 1.0 + 0.1 * jax.random.normal(ks[11], (DEPTH, SSD_HEADS), f32)
    ssd_norm_w = 1.0 + 0.02 * jax.random.normal(ks[12], (DEPTH, D_SSM), f32)
    conv_short_w = jax.random.normal(ks[13], (DEPTH, SHORT_CONV_K, D_SHORT), f32) * SHORT_CONV_K ** -0.5
    w_out = jax.random.normal(ks[14], (DEPTH, D_MIX, D_MODEL), f32) * D_MIX ** -0.5
    final_norm_w = 1.0 + 0.02 * jax.random.normal(ks[15], (D_MODEL,), f32)
    return {"x_prompt": x_prompt, "x_sample": x_sample,
            "state_ssm": state_ssm, "state_conv_ssd": state_conv_ssd,
            "state_conv_short": state_conv_short,
            "norm_w": norm_w, "w_in": w_in, "conv_ssd_w": conv_ssd_w, "conv_ssd_b": conv_ssd_b,
            "dt_bias": dt_bias, "a_log": a_log, "d_skip": d_skip, "ssd_norm_w": ssd_norm_w,
            "conv_short_w": conv_short_w, "w_out": w_out, "final_norm_w": final_norm_w}


def reference(x_prompt, x_sample, state_ssm, state_conv_ssd, state_conv_short,
              norm_w, w_in, conv_ssd_w, conv_ssd_b, dt_bias, a_log, d_skip, ssd_norm_w,
              conv_short_w, w_out, final_norm_w):
    hp = x_prompt
    hs = x_sample
    ssm_p, cs_p, csh_p, ssm_s, cs_s, csh_s = [], [], [], [], [], []
    for layer in range(DEPTH):
        params = (norm_w[layer], w_in[layer], conv_ssd_w[layer], conv_ssd_b[layer],
                  dt_bias[layer], a_log[layer], d_skip[layer], ssd_norm_w[layer],
                  conv_short_w[layer], w_out[layer])
        h0 = jnp.zeros((BATCH, SSD_HEADS, SSD_HEAD_DIM, SSD_D_STATE), hp.dtype)
        b0 = jnp.zeros((BATCH, SSD_CONV_K - 1, SSD_CONV_DIM), hp.dtype)
        c0 = jnp.zeros((BATCH, SHORT_CONV_K - 1, D_SHORT), hp.dtype)
        hp, a1, a2, a3 = mixer_layer(hp, h0, b0, c0, *params)
        hs, s1, s2, s3 = mixer_layer(hs, state_ssm[layer], state_conv_ssd[layer],
                                     state_conv_short[layer], *params)
        ssm_p.append(a1); cs_p.append(a2); csh_p.append(a3)
        ssm_s.append(s1); cs_s.append(s2); csh_s.append(s3)
    y_prompt = rmsnorm(hp, final_norm_w)
    y_sample = rmsnorm(hs, final_norm_w)
    return (y_prompt, y_sample,
            jnp.stack(ssm_p), jnp.stack(cs_p), jnp.stack(csh_p),
            jnp.stack(ssm_s), jnp.stack(cs_s), jnp.stack(csh_s))
```

```cpp
#include <hip/hip_runtime.h>
#include <hip/hip_cooperative_groups.h>
#include <cstdio>
#include <cstdint>
namespace cg = cooperative_groups;

#define LAS __attribute__((address_space(3)))
typedef unsigned short bf16_t;
typedef short bf16x8 __attribute__((ext_vector_type(8)));
typedef float f32x4 __attribute__((ext_vector_type(4)));
typedef float f32x2 __attribute__((ext_vector_type(2)));
typedef unsigned u32x4 __attribute__((ext_vector_type(4)));
typedef unsigned u32x2 __attribute__((ext_vector_type(2)));

constexpr int DM = 2048, MP = 8192, MS = 1024, MT = 9216;
constexpr int DIN = 13344;
constexpr int LDP = 13312;
constexpr int N1 = 13568;
constexpr int XB = 2048;
constexpr int UC = 5120, GC = 7168;
constexpr int DMIX = 4096;
constexpr float EPS = 1e-6f;
constexpr size_t O_YP = 0, O_YS = 16777216, O_SSMP = 18874368, O_CSP = 19922944, O_CSHP = 19959808,
                 O_SSMS = 19976192, O_CSS = 53530624, O_CSHS = 54710272, O_END = 55234560;
constexpr size_t MiB = 1u << 20;
constexpr size_t WS_WIN = 0, WS_WOUT = 54 * MiB, WS_H = 70 * MiB, WS_PROJ = 106 * MiB, WS_DT = 340 * MiB,
                 WS_YCAT = 342 * MiB, WS_S = 414 * MiB, WS_CDEC = 478 * MiB, WS_SSQ = 479 * MiB, WS_CTL = 481 * MiB, WS_END = 482 * MiB;
constexpr size_t WS_XTG = WS_WIN, WS_HPB = WS_H, WS_PART = WS_PROJ;
constexpr int LDS_BYTES = 147456 + 256, LDS_ST = 147456;

__device__ __forceinline__ unsigned cvt_pk_bf16(float lo, float hi) { unsigned r; asm volatile("v_cvt_pk_bf16_f32 %0, %1, %2" : "=v"(r) : "v"(lo), "v"(hi)); return r; }
__device__ __forceinline__ float bf_lo(unsigned v) { return __uint_as_float(v << 16); }
__device__ __forceinline__ float bf_hi(unsigned v) { return __uint_as_float(v & 0xffff0000u); }
__device__ __forceinline__ float bf2f(bf16_t v) { return __uint_as_float((unsigned)v << 16); }
__device__ __forceinline__ float silu_f(float x) { return x * __builtin_amdgcn_rcpf(1.0f + __expf(-x)); }
__device__ __forceinline__ float wave_sum(float v) {
#pragma unroll
    for (int o = 1; o < 64; o <<= 1) v += __shfl_xor(v, o);
    return v;
}
template <int CTRL> __device__ __forceinline__ float dpp_get(float v) { return __int_as_float(__builtin_amdgcn_update_dpp(0, __float_as_int(v), CTRL, 0xF, 0xF, true)); }
__device__ __forceinline__ float reduce32(float v) {
    v += dpp_get<0xB1>(v);
    v += dpp_get<0x4E>(v);
    v += dpp_get<0x141>(v);
    v += dpp_get<0x140>(v);
    v += __shfl_xor(v, 16);
    return v;
}
#define LDS_WAIT() asm volatile("s_waitcnt lgkmcnt(0)" ::: "memory")

namespace pg8 {
#define PG8_LAS __attribute__((address_space(3)))
constexpr int BM = 256, BK = 64, HALF = 128, HTB = HALF * BK * 2, NXCD = 8, WGM = 8;
__host__ __device__ __forceinline__ int lds_byte(int r, int c) { const int st = (r >> 4) * 2 + (c >> 5), rr = r & 15, cc = c & 31, ob = rr * 64 + cc * 2; return st * 1024 + (ob ^ (((ob >> 9) & 1) << 5)); }
__host__ __device__ __forceinline__ void stage_rc(int b, int& R, int& C) { const int st = b / 1024, sb = b % 1024, swz = sb ^ (((sb >> 9) & 1) << 5); R = (st >> 1) * 16 + swz / 64; C = (st & 1) * 32 + (swz % 64) / 2; }
__host__ __device__ __forceinline__ int perm32(int rho) { const int n = rho >> 4, i = rho & 15; return 8 * (i >> 2) + 4 * n + (i & 3); }
struct Unit { int pm, pn; };
struct Gemm { const bf16_t* A; const bf16_t* Bt; int M, N, K, ld; };
struct StaticOrder {
    int nM, nN, nwg, G, c;
    __host__ __device__ void init(int M, int N, int G_, int c_) { nM = M / BM; nN = N / BM; nwg = nM * nN; G = G_; c = c_; }
    __host__ __device__ bool next(int i, Unit& u) const {
        const long L = (long)i * G + c; if (L >= nwg) return false;
        int wgid = (int)L; { const int q = nwg / NXCD, r = nwg % NXCD, xcd = wgid % NXCD, off = wgid / NXCD; wgid = (xcd < r ? xcd * (q + 1) : r * (q + 1) + (xcd - r) * q) + off; }
        const int nig = WGM * nN, gid = wgid / nig, fm = gid * WGM, gsz = (nM - fm) < WGM ? (nM - fm) : WGM;
        u.pm = fm + ((wgid % nig) % gsz); u.pn = (wgid % nig) / gsz; return true;
    }
};

struct SplitOrder {
    int G, c;
    __host__ __device__ bool next(int i, Unit& u) const { const long L = (long)i * G + c; if (L >= 256) return false; const int t = (int)L >> 3; u.pm = 32 + (t >> 3); u.pn = t & 7; return true; }
};
template <class Epi, class Sched>
__device__ __forceinline__ void gemm_phase(PG8_LAS unsigned char* lds, const Gemm g, const Sched& S, const Epi& E) {
    int tid = threadIdx.x; asm volatile("" : "+v"(tid));
    const int wid = __builtin_amdgcn_readfirstlane(tid >> 6), lane = tid & 63, wr = wid >> 2, wc = wid & 3, fr = lane & 15, fq = lane >> 4;
    const int K = g.ld, nt = g.K / BK;
    unsigned voffA[2], voffB[2];
#pragma unroll
    for (int i = 0; i < 2; ++i) { int R, C; stage_rc(tid * 16 + i * 8192, R, C); const int Rb = (R & ~31) + perm32(R & 31);
        voffA[i] = (unsigned)(R * K + C) * 2u; voffB[i] = (unsigned)(Rb * K + C) * 2u; }
    const size_t kstep = (size_t)(BK * 2);
    const size_t hstep = (size_t)HALF * K * 2;
    const size_t tstep = 2 * hstep;
    const unsigned ldsw = (unsigned)wid * 1024u;
    const int aoff = lds_byte(wr * 64 + fr, fq * 8), boff = lds_byte(wc * 32 + fr, fq * 8);
#define PG8_SA(b, h) (((b) * 2 + (h)) * HTB)
#define PG8_SB(b, h) ((4 + (b) * 2 + (h)) * HTB)
#define PG8_STAGE(bufoff, gbase, voff) do { _Pragma("unroll") for (int _i = 0; _i < 2; ++_i) \
        __builtin_amdgcn_global_load_lds((const unsigned*)((const char*)(gbase) + (voff)[_i]), (PG8_LAS unsigned*)(lds + (bufoff) + ldsw + _i * 8192), 16, 0, 0); } while (0)
#define PG8_LDA(dst, b, h) do { _Pragma("unroll") for (int m = 0; m < 4; ++m) _Pragma("unroll") for (int k = 0; k < 2; ++k) dst[m][k] = *(const PG8_LAS bf16x8*)(lds + PG8_SA(b, h) + aoff + m * 2048 + k * 1024); } while (0)
#define PG8_LDB(dst, b, h) do { _Pragma("unroll") for (int n = 0; n < 2; ++n) _Pragma("unroll") for (int k = 0; k < 2; ++k) dst[n][k] = *(const PG8_LAS bf16x8*)(lds + PG8_SB(b, h) + boff + n * 2048 + k * 1024); } while (0)
#define PG8_MMA(ai, bj, At, Bt) do { __builtin_amdgcn_s_setprio(1); _Pragma("unroll") for (int m = 0; m < 4; ++m) _Pragma("unroll") for (int n = 0; n < 2; ++n) _Pragma("unroll") for (int k = 0; k < 2; ++k) \
        acc[ai][bj][m][n] = __builtin_amdgcn_mfma_f32_16x16x32_bf16(Bt[n][k], At[m][k], acc[ai][bj][m][n], 0, 0, 0); __builtin_amdgcn_s_setprio(0); } while (0)
#define PG8_WAIT_V(n) asm volatile("s_waitcnt vmcnt(" #n ")" ::: "memory")
#define PG8_WAIT_L(n) asm volatile("s_waitcnt lgkmcnt(" #n ")" ::: "memory")
#define PG8_BAR __builtin_amdgcn_s_barrier()
#define PG8_SCHED __builtin_amdgcn_sched_barrier(0)
    Unit cur, nxt; int ui = 0;
    if (!S.next(0, cur)) return;
    f32x4 acc[2][2][4][2];
#pragma unroll
    for (int a = 0; a < 2; ++a)
#pragma unroll
        for (int b = 0; b < 2; ++b)
#pragma unroll
            for (int m = 0; m < 4; ++m)
#pragma unroll
                for (int n = 0; n < 2; ++n) acc[a][b][m][n] = (f32x4){0.f, 0.f, 0.f, 0.f};
    bf16x8 At[4][2], B0[2][2], B1[2][2];
    const char* cA = (const char*)g.A + (size_t)cur.pm * tstep; const char* cB = (const char*)g.Bt + (size_t)cur.pn * tstep;
    PG8_STAGE(PG8_SB(0, 0), cB, voffB); PG8_STAGE(PG8_SB(0, 1), cB + hstep, voffB); PG8_STAGE(PG8_SA(0, 0), cA, voffA); PG8_STAGE(PG8_SA(0, 1), cA + hstep, voffA);
    if (wr == 1) PG8_BAR;
    PG8_WAIT_V(2); PG8_BAR;
    PG8_STAGE(PG8_SB(1, 0), cB + kstep, voffB); PG8_STAGE(PG8_SA(1, 0), cA + kstep, voffA); PG8_STAGE(PG8_SB(1, 1), cB + hstep + kstep, voffB);
    PG8_WAIT_V(6); PG8_BAR;
    for (;;) {
        const bool has_next = S.next(ui + 1, nxt);
        const char* nA = has_next ? (const char*)g.A + (size_t)nxt.pm * tstep : cA; const char* nB = has_next ? (const char*)g.Bt + (size_t)nxt.pn * tstep : cB;
        for (int t = 0; t < nt; t += 2) {
            const bool last = (t == nt - 2);
            const char* a1 = cA + (size_t)(t + 1) * kstep;
            const char* a2 = last ? nA : cA + (size_t)(t + 2) * kstep; const char* b2 = last ? nB : cB + (size_t)(t + 2) * kstep;
            const char* a3 = a2 + kstep; const char* b3 = b2 + kstep;
            PG8_LDB(B0, 0, 0); PG8_LDB(B1, 0, 1); PG8_SCHED; PG8_LDA(At, 0, 0); PG8_STAGE(PG8_SA(1, 1), a1 + hstep, voffA);
            PG8_WAIT_V(8); PG8_WAIT_L(0); PG8_BAR; PG8_MMA(0, 0, At, B0); PG8_MMA(0, 1, At, B1); PG8_BAR; PG8_SCHED;
            PG8_LDA(At, 0, 1); PG8_STAGE(PG8_SB(0, 0), b2, voffB); PG8_STAGE(PG8_SB(0, 1), b2 + hstep, voffB); PG8_STAGE(PG8_SA(0, 0), a2, voffA);
            PG8_WAIT_V(8); PG8_WAIT_L(0); PG8_BAR; PG8_MMA(1, 0, At, B0); PG8_MMA(1, 1, At, B1); PG8_BAR; PG8_SCHED;
            PG8_LDB(B0, 1, 0); PG8_LDB(B1, 1, 1); PG8_SCHED; PG8_LDA(At, 1, 0); PG8_STAGE(PG8_SA(0, 1), a2 + hstep, voffA);
            PG8_WAIT_V(8); PG8_WAIT_L(0); PG8_BAR; PG8_MMA(0, 0, At, B0); PG8_MMA(0, 1, At, B1); PG8_BAR; PG8_SCHED;
            PG8_LDA(At, 1, 1); PG8_STAGE(PG8_SB(1, 0), b3, voffB); PG8_STAGE(PG8_SB(1, 1), b3 + hstep, voffB); PG8_STAGE(PG8_SA(1, 0), a3, voffA);
            PG8_WAIT_V(8); PG8_WAIT_L(0); PG8_BAR; PG8_MMA(1, 0, At, B0); PG8_MMA(1, 1, At, B1); PG8_BAR; PG8_SCHED;
        }
        if (wr == 0) PG8_BAR;
        E(acc, cur, wr, wc, fr, fq);
        if (!has_next) break;
#pragma unroll
        for (int a = 0; a < 2; ++a)
#pragma unroll
            for (int b = 0; b < 2; ++b)
#pragma unroll
                for (int m = 0; m < 4; ++m)
#pragma unroll
                    for (int n = 0; n < 2; ++n) acc[a][b][m][n] = (f32x4){0.f, 0.f, 0.f, 0.f};
        cur = nxt; cA = nA; cB = nB; ++ui;
        if (wr == 1) PG8_BAR;
    }
    PG8_WAIT_V(0);
    PG8_BAR;
#undef PG8_SA
#undef PG8_SB
#undef PG8_STAGE
#undef PG8_LDA
#undef PG8_LDB
#undef PG8_MMA
#undef PG8_WAIT_V
#undef PG8_WAIT_L
#undef PG8_BAR
#undef PG8_SCHED
}

struct Epi1 {
    bf16_t* P; float* DT; const float* dt_bias;
    __device__ __forceinline__ void operator()(const f32x4 (&acc)[2][2][4][2], const Unit& u, int wr, int wc, int fr, int fq) const {
        const int row0 = u.pm * BM + wr * 64 + fr;
        if (u.pn < 20) {
            const int col0 = u.pn * BM + wc * 32 + 8 * fq;
#pragma unroll
            for (int ai = 0; ai < 2; ++ai)
#pragma unroll
                for (int m = 0; m < 4; ++m) { bf16_t* rowp = P + (size_t)(row0 + ai * HALF + m * 16) * LDP + col0;
#pragma unroll
                    for (int bj = 0; bj < 2; ++bj) { f32x4 v0 = acc[ai][bj][m][0], v1 = acc[ai][bj][m][1];
                        if (u.pn < 8) {
#pragma unroll
                            for (int e = 0; e < 4; ++e) { v0[e] = silu_f(v0[e]); v1[e] = silu_f(v1[e]); } }
                        u32x4 w; w.x = cvt_pk_bf16(v0[0], v0[1]); w.y = cvt_pk_bf16(v0[2], v0[3]); w.z = cvt_pk_bf16(v1[0], v1[1]); w.w = cvt_pk_bf16(v1[2], v1[3]);
                        *(u32x4*)(rowp + bj * HALF) = w; } }
        } else if (u.pn < 52) {
            const int ch0 = (u.pn - 20) * 64 + 16 * wc + 4 * fq;
#pragma unroll
            for (int ai = 0; ai < 2; ++ai)
#pragma unroll
                for (int m = 0; m < 4; ++m) { bf16_t* rowp = P + (size_t)(row0 + ai * HALF + m * 16) * LDP + ch0;
                    const f32x4 z = acc[ai][0][m][0], b = acc[ai][0][m][1], c = acc[ai][1][m][0], v = acc[ai][1][m][1];
                    const f32x4 uu = c * v; f32x4 gz;
#pragma unroll
                    for (int e = 0; e < 4; ++e) gz[e] = b[e] * silu_f(z[e]);
                    u32x2 wu, wg; wu.x = cvt_pk_bf16(uu[0], uu[1]); wu.y = cvt_pk_bf16(uu[2], uu[3]); wg.x = cvt_pk_bf16(gz[0], gz[1]); wg.y = cvt_pk_bf16(gz[2], gz[3]);
                    *(u32x2*)(rowp + UC) = wu; *(u32x2*)(rowp + GC) = wg; }
        } else if (wc == 0) {
            f32x4 bv[2];
#pragma unroll
            for (int n = 0; n < 2; ++n) bv[n] = *(const f32x4*)(dt_bias + 8 * fq + 4 * n);
#pragma unroll
            for (int ai = 0; ai < 2; ++ai)
#pragma unroll
                for (int m = 0; m < 4; ++m) { float* rowp = DT + (size_t)(row0 + ai * HALF + m * 16) * 32 + 8 * fq;
#pragma unroll
                    for (int n = 0; n < 2; ++n) { f32x4 v = acc[ai][0][m][n] + bv[n], o;
#pragma unroll
                        for (int e = 0; e < 4; ++e) o[e] = v[e] > 20.f ? v[e] : log1pf(__expf(v[e]));
                        *(f32x4*)(rowp + 4 * n) = o; } }
        }
    }
};
struct Epi2 {
    const float* XP; float* OUT;
    __device__ __forceinline__ void operator()(const f32x4 (&acc)[2][2][4][2], const Unit& u, int wr, int wc, int fr, int fq) const {
        const int row0 = u.pm * BM + wr * 64 + fr, col0 = u.pn * BM + wc * 32 + 8 * fq;
#pragma unroll
        for (int ai = 0; ai < 2; ++ai)
#pragma unroll
            for (int m = 0; m < 4; ++m) { const int r = row0 + ai * HALF + m * 16;
                const float* xr = XP + (size_t)r * DM + col0; float* orow = OUT + (size_t)r * DM + col0;
#pragma unroll
                for (int bj = 0; bj < 2; ++bj) {
                    *(f32x4*)(orow + bj * HALF) = acc[ai][bj][m][0] + *(const f32x4*)(xr + bj * HALF);
                    *(f32x4*)(orow + bj * HALF + 4) = acc[ai][bj][m][1] + *(const f32x4*)(xr + bj * HALF + 4); } }
    }
};
struct Epi2f {
    const float* XP; float* OUT; const float* FW; float* SSQ; unsigned* CNT; PG8_LAS unsigned char* LDSR;
    __device__ __forceinline__ void operator()(const f32x4 (&acc_)[2][2][4][2], const Unit& u, int wr, int wc, int fr, int fq) const {
        f32x4 (&acc)[2][2][4][2] = const_cast<f32x4 (&)[2][2][4][2]>(acc_);
        const int row0 = u.pm * BM + wr * 64 + fr, col0 = u.pn * BM + wc * 32 + 8 * fq;
#pragma unroll
        for (int ai = 0; ai < 2; ++ai)
#pragma unroll
            for (int m = 0; m < 4; ++m) { const int r = row0 + ai * HALF + m * 16; const float* xr = XP + (size_t)r * DM + col0; float ss = 0.f;
#pragma unroll
                for (int bj = 0; bj < 2; ++bj) {
                    const f32x4 v0 = acc[ai][bj][m][0] + __builtin_nontemporal_load((const f32x4*)(xr + bj * HALF)), v1 = acc[ai][bj][m][1] + __builtin_nontemporal_load((const f32x4*)(xr + bj * HALF + 4));
                    acc[ai][bj][m][0] = v0; acc[ai][bj][m][1] = v1;
                    ss += (v0[0] * v0[0] + v0[1] * v0[1]) + (v0[2] * v0[2] + v0[3] * v0[3]) + (v1[0] * v1[0] + v1[1] * v1[1]) + (v1[2] * v1[2] + v1[3] * v1[3]); }
                ss += __shfl_xor(ss, 16); ss += __shfl_xor(ss, 32);
                if (fq == 0) __hip_atomic_store(SSQ + (size_t)r * 32 + u.pn * 4 + wc, ss, __ATOMIC_RELAXED, __HIP_MEMORY_SCOPE_AGENT); }
        asm volatile("s_waitcnt vmcnt(0)" ::: "memory");
        __syncthreads();
        if (threadIdx.x == 0) {
            unsigned* c = CNT + 64 * u.pm;
            (void)__hip_atomic_fetch_add(c, 1u, __ATOMIC_RELAXED, __HIP_MEMORY_SCOPE_AGENT);
            unsigned sp = 0;
            while (__hip_atomic_load(c, __ATOMIC_RELAXED, __HIP_MEMORY_SCOPE_AGENT) < 8u) { __builtin_amdgcn_s_sleep(1); if (++sp > (1u << 22)) break; }
        }
        __syncthreads();
        float rstd[2][4];
        {
            const int tid = threadIdx.x, prow = tid >> 1, half = tid & 1;
            const unsigned long long* sq = (const unsigned long long*)(SSQ + (size_t)(u.pm * BM + prow) * 32 + half * 16);
            float p = 0.f;
#pragma unroll
            for (int k = 0; k < 8; ++k) { const unsigned long long v = __hip_atomic_load(sq + k, __ATOMIC_RELAXED, __HIP_MEMORY_SCOPE_AGENT); p += __uint_as_float((unsigned)v) + __uint_as_float((unsigned)(v >> 32)); }
            p += __shfl_xor(p, 1);
            if (half == 0) ((PG8_LAS float*)LDSR)[prow] = rsqrtf(p * (1.f / DM) + EPS);
            __syncthreads();
#pragma unroll
            for (int ai = 0; ai < 2; ++ai)
#pragma unroll
                for (int m = 0; m < 4; ++m) rstd[ai][m] = ((PG8_LAS const float*)LDSR)[ai * HALF + wr * 64 + m * 16 + fr];
        }
        f32x4 fw[2][2];
#pragma unroll
        for (int bj = 0; bj < 2; ++bj)
#pragma unroll
            for (int n = 0; n < 2; ++n) fw[bj][n] = *(const f32x4*)(FW + col0 + bj * HALF + 4 * n);
#pragma unroll
        for (int ai = 0; ai < 2; ++ai)
#pragma unroll
            for (int m = 0; m < 4; ++m) { float* orow = OUT + (size_t)(row0 + ai * HALF + m * 16) * DM + col0;
#pragma unroll
                for (int bj = 0; bj < 2; ++bj) { *(f32x4*)(orow + bj * HALF) = acc[ai][bj][m][0] * rstd[ai][m] * fw[bj][0]; *(f32x4*)(orow + bj * HALF + 4) = acc[ai][bj][m][1] * rstd[ai][m] * fw[bj][1]; } }
    }
};
struct Epi2s {
    bf16_t* PART;
    __device__ __forceinline__ void operator()(const f32x4 (&acc)[2][2][4][2], const Unit& u, int wr, int wc, int fr, int fq) const {
        const int row0 = (u.pm - 32) * BM + wr * 64 + fr, col0 = u.pn * BM + wc * 32 + 8 * fq;
#pragma unroll
        for (int ai = 0; ai < 2; ++ai)
#pragma unroll
            for (int m = 0; m < 4; ++m) { bf16_t* orow = PART + (size_t)(row0 + ai * HALF + m * 16) * DM + col0;
#pragma unroll
                for (int bj = 0; bj < 2; ++bj) { const f32x4 v0 = acc[ai][bj][m][0], v1 = acc[ai][bj][m][1];
                    u32x4 w; w.x = cvt_pk_bf16(v0[0], v0[1]); w.y = cvt_pk_bf16(v0[2], v0[3]); w.z = cvt_pk_bf16(v1[0], v1[1]); w.w = cvt_pk_bf16(v1[2], v1[3]);
                    *(u32x4*)(orow + bj * HALF) = w; } }
    }
};
}

__device__ __forceinline__ int drow_in(int sc) {
    if (sc < 5120) return sc;
    const int s2 = sc - 5152, kind = s2 >> 11, ch = s2 & 2047;
    return 5120 + (ch >> 6) * 256 + 128 * (kind >> 1) + 4 * (kind & 1) + 32 * ((ch >> 4) & 3) + 8 * ((ch >> 2) & 3) + (ch & 3);
}
struct TItem { const float* src; bf16_t* dst; int K, N, n0; };
__device__ __forceinline__ TItem titem(int it, const float* win, const float* wout, bf16_t* WinT, bf16_t* WoutT) {
    constexpr int I_IN = 32 * 26;
    TItem t;
    if (it < I_IN) { const int kb = it / 26, nb = it % 26, nd = nb * 512, ns = nd < 5120 ? nd : nd + 32; t.src = win + (size_t)(kb * 64) * DIN + ns; t.dst = WinT + kb * 64; t.K = 2048; t.N = DIN; t.n0 = ns; }
    else { const int r = it - I_IN, kb = r / 4, nb = r % 4; t.src = wout + (size_t)(kb * 64) * 2048 + nb * 512; t.dst = WoutT + (size_t)(nb * 512) * 4096 + kb * 64; t.K = 4096; t.N = 2048; t.n0 = -1; }
    return t;
}
__device__ __forceinline__ void transpose_items(int first, int it0, int it1, int stride, const float* win, const float* wout, bf16_t* WinT, bf16_t* WoutT, float* scr, int tid) {
    const int r = tid >> 7, q = tid & 127, c = tid & 7, nr = tid >> 3;
    f32x4 v[16];
    int it = it0 + first;
    TItem cur = titem(it < it1 ? it : it0, win, wout, WinT, WoutT);
    if (it < it1) {
#pragma unroll
        for (int i = 0; i < 16; ++i) v[i] = __builtin_nontemporal_load((const f32x4*)(cur.src + (size_t)(4 * i + r) * cur.N + 4 * q));
    }
    for (; it < it1; it += stride) {
        __syncthreads();
#pragma unroll
        for (int i = 0; i < 16; ++i) { float* s = scr + (4 * i + r) * 513 + 4 * q; s[0] = v[i][0]; s[1] = v[i][1]; s[2] = v[i][2]; s[3] = v[i][3]; }
        const TItem me = cur;
        if (it + stride < it1) { cur = titem(it + stride, win, wout, WinT, WoutT);
#pragma unroll
            for (int i = 0; i < 16; ++i) v[i] = __builtin_nontemporal_load((const f32x4*)(cur.src + (size_t)(4 * i + r) * cur.N + 4 * q)); }
        __syncthreads();
#pragma unroll
        for (int j = 0; j < 8; ++j) { const int n = nr + 64 * j; const float* s = scr + (8 * c) * 513 + n;
            u32x4 o; o.x = cvt_pk_bf16(s[0 * 513], s[1 * 513]); o.y = cvt_pk_bf16(s[2 * 513], s[3 * 513]); o.z = cvt_pk_bf16(s[4 * 513], s[5 * 513]); o.w = cvt_pk_bf16(s[6 * 513], s[7 * 513]);
            const int dr = me.n0 >= 0 ? drow_in(me.n0 + n) : n;
            *(u32x4*)(me.dst + (size_t)dr * me.K + 8 * c) = o; }
    }
    __syncthreads();
}
constexpr int T_IN = 32 * 26, T_ALL = 32 * 26 + 64 * 4;
__device__ __forceinline__ void phase0(const float* xp, const float* xs, const float* normw, const float* win, const float* wout,
                                       bf16_t* WinT, bf16_t* WoutT, bf16_t* H, unsigned char* lds, int tid, int lane, int wave, int G) {
    float* scr = (float*)lds;
    const int gw = blockIdx.x * 8 + wave, NGW = G * 8;
    transpose_items((int)blockIdx.x, 0, T_IN, G, win, wout, WinT, WoutT, scr, tid);
    const int gt = blockIdx.x * 512 + tid, NGT = G * 512;
    for (int idx = gt; idx < 65536; idx += NGT) { const int n = idx & 31, k = idx >> 5; WinT[(size_t)(13312 + n) * 2048 + k] = (bf16_t)(cvt_pk_bf16(win[(size_t)k * DIN + 5120 + n], 0.f) & 0xffffu); }
    for (int idx = gt; idx < 57344; idx += NGT) ((u32x4*)(WinT + (size_t)13344 * 2048))[idx] = (u32x4){0u, 0u, 0u, 0u};
    {
        f32x4 nv[8];
        if (gw < MT) { const f32x4* xr = (const f32x4*)(gw < MP ? xp + (size_t)gw * DM : xs + (size_t)(gw - MP) * DM) + lane;
#pragma unroll
            for (int j = 0; j < 8; ++j) nv[j] = __builtin_nontemporal_load(xr + 64 * j); }
        for (int m = gw; m < MT; m += NGW) {
            f32x4 v[8]; float ss = 0.f;
#pragma unroll
            for (int j = 0; j < 8; ++j) { v[j] = nv[j]; ss += (v[j][0] * v[j][0] + v[j][1] * v[j][1]) + (v[j][2] * v[j][2] + v[j][3] * v[j][3]); }
            const int mn = m + NGW;
            if (mn < MT) { const f32x4* xr = (const f32x4*)(mn < MP ? xp + (size_t)mn * DM : xs + (size_t)(mn - MP) * DM) + lane;
#pragma unroll
                for (int j = 0; j < 8; ++j) nv[j] = __builtin_nontemporal_load(xr + 64 * j); }
            const float rs = rsqrtf(wave_sum(ss) * (1.f / DM) + EPS);
            u32x2* o = (u32x2*)(H + (size_t)m * DM) + lane;
#pragma unroll
            for (int j = 0; j < 8; ++j) { const f32x4 w = ((const f32x4*)normw)[64 * j + lane]; u32x2 p; p.x = cvt_pk_bf16(v[j][0] * rs * w[0], v[j][1] * rs * w[1]); p.y = cvt_pk_bf16(v[j][2] * rs * w[2], v[j][3] * rs * w[3]); o[64 * j] = p; }
        }
    }
}

constexpr int PITCH = 136;
constexpr int L_BM = 34816, L_XT = 69632, L_HP = 87040, L_DT = 104448, L_AC = 108544, L_SC = 112640;
constexpr int C_CM = 0, C_MW = 34816, C_X0 = 69632, C_H0 = 87040, C_X1 = 104448, C_H1 = 121856, C_DT = 139264, C_AC = 143360;

template <int ODT, int OAC, int OSC>
__device__ __forceinline__ void ssd_setup(const float* DT, const float* alog, int R0, int g, unsigned char* lds, int lane, int w) {
    const int hg = g * 8 + w; const float a = -expf(alog[hg]);
    const float dt0 = DT[(size_t)(R0 + 2 * lane) * 32 + hg], dt1 = DT[(size_t)(R0 + 2 * lane + 1) * 32 + hg];
    const float la0 = dt0 * a, la1 = dt1 * a; float s = la0 + la1;
#pragma unroll
    for (int o = 1; o < 64; o <<= 1) { const float t = __shfl_up(s, o); if (lane >= o) s += t; }
    const float ac1 = s, ac0 = s - la1, tot = __shfl(s, 63);
    ((f32x2*)(lds + ODT))[w * 64 + lane] = (f32x2){dt0, dt1};
    ((f32x2*)(lds + OAC))[w * 64 + lane] = (f32x2){ac0, ac1};
    if (OSC >= 0) ((f32x2*)(lds + (OSC >= 0 ? OSC : 0)))[w * 64 + lane] = (f32x2){dt0 * __expf(tot - ac0), dt1 * __expf(tot - ac1)};
}

struct ConvRaw { unsigned v[11]; f32x2 w[4]; f32x2 b; };
__device__ __forceinline__ void conv_load(ConvRaw& r, const bf16_t* src, bool first, int ls, const float* cw, const float* cb) {
#pragma unroll
    for (int i = 0; i < 11; ++i) { const int l = ls - 3 + i; unsigned v = 0u; if (!(first && l < 0)) v = *(const unsigned*)(src + (long)l * LDP); r.v[i] = v; }
#pragma unroll
    for (int i = 0; i < 4; ++i) r.w[i] = *(const f32x2*)(cw + i * 3072);
    r.b = *(const f32x2*)cb;
}
__device__ __forceinline__ void conv_compute(const ConvRaw& r, float (&o0)[8], float (&o1)[8]) {
    float lo[11], hi[11];
#pragma unroll
    for (int i = 0; i < 11; ++i) { lo[i] = bf_lo(r.v[i]); hi[i] = bf_hi(r.v[i]); }
#pragma unroll
    for (int j = 0; j < 8; ++j) {
        o0[j] = silu_f(r.b[0] + r.w[0][0] * lo[j] + r.w[1][0] * lo[j + 1] + r.w[2][0] * lo[j + 2] + r.w[3][0] * lo[j + 3]);
        o1[j] = silu_f(r.b[1] + r.w[0][1] * hi[j] + r.w[1][1] * hi[j + 1] + r.w[2][1] * hi[j + 2] + r.w[3][1] * hi[j + 3]);
    }
}
__device__ __forceinline__ u32x4 pack8(const float (&o)[8]) { u32x4 p; p.x = cvt_pk_bf16(o[0], o[1]); p.y = cvt_pk_bf16(o[2], o[3]); p.z = cvt_pk_bf16(o[4], o[5]); p.w = cvt_pk_bf16(o[6], o[7]); return p; }
template <bool TR>
__device__ __forceinline__ void conv_task(const bf16_t* src, bool first, int ls, const float* cw, const float* cb, bf16_t* img, int chl) {
    ConvRaw r; conv_load(r, src, first, ls, cw, cb);
    float o0[8], o1[8]; conv_compute(r, o0, o1);
    if (TR) { *(u32x4*)(img + chl * PITCH + ls) = pack8(o0); *(u32x4*)(img + (chl + 1) * PITCH + ls) = pack8(o1); }
    else {
#pragma unroll
        for (int j = 0; j < 8; ++j) *(unsigned*)(img + (ls + j) * PITCH + chl) = cvt_pk_bf16(o0[j], o1[j]);
    }
}

__device__ __forceinline__ void ssd_passA(int u, const bf16_t* PROJ, const float* DT, const float* alog, const float* cw, const float* cbias,
                                          float* S, float* CDEC, bf16_t* XTg, unsigned char* lds, int tid, int lane, int w) {
    const int b = u >> 6, c = (u >> 2) & 15, g = u & 3, R0 = b * 2048 + c * 128; const bool first = (c == 0);
    const int fr = lane & 15, fq = lane >> 4;
    bf16_t* BT = (bf16_t*)(lds + L_BM);
    const bf16_t* src0 = PROJ + (size_t)R0 * LDP + XB;
    ssd_setup<L_DT, L_AC, L_SC>(DT, alog, R0, g, lds, lane, w);
#pragma unroll
    for (int i = 0; i < 2; ++i) { const int task = tid + 512 * i, pr = task & 63, lg = task >> 6, ch = 2048 + g * 128 + 2 * pr;
        conv_task<true>(src0 + ch, first, lg * 8, cw + ch, cbias + ch, BT, 2 * pr); }
    const int pr = tid & 31, lg = tid >> 5;
    ConvRaw raw; { const int ch = g * 512 + 2 * pr; conv_load(raw, src0 + ch, first, lg * 8, cw + ch, cbias + ch); }
    __syncthreads();
    const int pw = w & 3, nb = (w >> 2) * 64;
    bf16x8 btf[4][4];
#pragma unroll
    for (int nt = 0; nt < 4; ++nt)
#pragma unroll
        for (int ks = 0; ks < 4; ++ks) btf[nt][ks] = *(const bf16x8*)(BT + (nb + 16 * nt + fr) * PITCH + 32 * ks + 8 * fq);
    for (int h8 = 0; h8 < 8; ++h8) {
        const int hg = g * 8 + h8; const size_t tile = (size_t)((b * 16 + c) * 32 + hg) * 8192;
        float o0[8], o1[8]; conv_compute(raw, o0, o1);
        if (h8 < 7) { const int ch = g * 512 + (h8 + 1) * 64 + 2 * pr; conv_load(raw, src0 + ch, first, lg * 8, cw + ch, cbias + ch); }
        { bf16_t* xg = XTg + tile + (2 * pr) * 128 + lg * 8; *(u32x4*)xg = pack8(o0); *(u32x4*)(xg + 128) = pack8(o1); }
        { const float* sc = (const float*)(lds + L_SC) + h8 * 128 + lg * 8; const f32x4 s0 = *(const f32x4*)sc, s1 = *(const f32x4*)(sc + 4);
#pragma unroll
          for (int j = 0; j < 4; ++j) { o0[j] *= s0[j]; o1[j] *= s0[j]; o0[4 + j] *= s1[j]; o1[4 + j] *= s1[j]; } }
        bf16_t* XT = (bf16_t*)(lds + ((h8 & 1) ? L_HP : L_XT));
        *(u32x4*)(XT + (2 * pr) * PITCH + lg * 8) = pack8(o0); *(u32x4*)(XT + (2 * pr + 1) * PITCH + lg * 8) = pack8(o1);
        __syncthreads();
        f32x4 acc[4];
#pragma unroll
        for (int nt = 0; nt < 4; ++nt) acc[nt] = (f32x4){0.f, 0.f, 0.f, 0.f};
#pragma unroll
        for (int ks = 0; ks < 4; ++ks) { const bf16x8 xf = *(const bf16x8*)(XT + (16 * pw + fr) * PITCH + 32 * ks + 8 * fq);
#pragma unroll
            for (int nt = 0; nt < 4; ++nt) acc[nt] = __builtin_amdgcn_mfma_f32_16x16x32_bf16(btf[nt][ks], xf, acc[nt], 0, 0, 0); }
        float* sp = S + tile + (16 * pw + fr) * 128 + nb + 4 * fq;
#pragma unroll
        for (int nt = 0; nt < 4; ++nt) *(f32x4*)(sp + 16 * nt) = acc[nt];
        if (tid == 0) CDEC[(b * 16 + c) * 32 + hg] = __expf(((const float*)(lds + L_AC))[h8 * 128 + 127]);
    }
    __syncthreads();
}

__device__ __forceinline__ void ssd_passC(int u, const bf16_t* PROJ, const float* DT, const float* alog, const float* cw, const float* cbias, const float* dskip,
                                          const float* snw, const bf16_t* XTg, const bf16_t* HPB, bf16_t* YCAT, unsigned char* lds, int tid, int lane, int w) {
    const int b = u >> 6, c = (u >> 2) & 15, g = u & 3, R0 = b * 2048 + c * 128; const bool first = (c == 0);
    const int fr = lane & 15, fq = lane >> 4, l0 = 16 * w;
    bf16_t* Cm = (bf16_t*)(lds + C_CM); bf16_t* Bm = (bf16_t*)(lds + C_X0);
    bf16_t* Mw = (bf16_t*)(lds + C_MW + w * 4352);
    const float* DTs = (const float*)(lds + C_DT); const float* ACs = (const float*)(lds + C_AC);
    const bf16_t* src0 = PROJ + (size_t)R0 * LDP + XB;
    const size_t row = (size_t)(R0 + l0 + fr);
    const size_t tile0 = (size_t)((b * 16 + c) * 32 + g * 8) * 8192;
    ssd_setup<C_DT, C_AC, -1>(DT, alog, R0, g, lds, lane, w);
#pragma unroll
    for (int i = 0; i < 2; ++i) { const int task = tid + 512 * i, pr = task & 63, lg = task >> 6;
        const int chB = 2048 + g * 128 + 2 * pr, chC = 2560 + g * 128 + 2 * pr;
        conv_task<false>(src0 + chB, first, lg * 8, cw + chB, cbias + chB, Bm, 2 * pr);
        conv_task<false>(src0 + chC, first, lg * 8, cw + chC, cbias + chC, Cm, 2 * pr); }
    u32x4 xr[2], hr[2]; u32x2 zn[4];
#define PC_LOADS(h8n) do { const size_t _t = tile0 + (size_t)(h8n) * 8192; \
        _Pragma("unroll") for (int _i = 0; _i < 2; ++_i) { xr[_i] = __builtin_nontemporal_load((const u32x4*)(XTg + _t) + tid + 512 * _i); hr[_i] = __builtin_nontemporal_load((const u32x4*)(HPB + _t) + tid + 512 * _i); } \
        _Pragma("unroll") for (int _p = 0; _p < 4; ++_p) zn[_p] = *(const u32x2*)(PROJ + row * LDP + (g * 8 + (h8n)) * 64 + 16 * _p + 4 * fq); } while (0)
    PC_LOADS(0);
    __syncthreads();
    bf16x8 cfrag[4];
#pragma unroll
    for (int ks = 0; ks < 4; ++ks) cfrag[ks] = *(const bf16x8*)(Cm + (l0 + fr) * PITCH + 32 * ks + 8 * fq);
    f32x4 cbv[8];
#pragma unroll
    for (int ts = 0; ts < 8; ++ts) { cbv[ts] = (f32x4){0.f, 0.f, 0.f, 0.f};
        if (ts <= w) {
#pragma unroll
            for (int ks = 0; ks < 4; ++ks) { const bf16x8 bfr = *(const bf16x8*)(Bm + (16 * ts + fr) * PITCH + 32 * ks + 8 * fq);
                cbv[ts] = __builtin_amdgcn_mfma_f32_16x16x32_bf16(bfr, cfrag[ks], cbv[ts], 0, 0, 0); } } }
    __syncthreads();
    float ssq = 0.f;
    for (int h8 = 0; h8 < 8; ++h8) {
        const int hg = g * 8 + h8;
        bf16_t* XT = (bf16_t*)(lds + ((h8 & 1) ? C_X1 : C_X0)); bf16_t* HP = (bf16_t*)(lds + ((h8 & 1) ? C_H1 : C_H0));
#pragma unroll
        for (int i = 0; i < 2; ++i) { const int piece = tid + 512 * i, p = piece >> 4, l8 = piece & 15;
            *(u32x4*)(XT + p * PITCH + 8 * l8) = xr[i]; *(u32x4*)(HP + p * PITCH + 8 * l8) = hr[i]; }
        u32x2 zc[4];
#pragma unroll
        for (int pt = 0; pt < 4; ++pt) zc[pt] = zn[pt];
        const float ac_l = ACs[h8 * 128 + l0 + fr];
#pragma unroll
        for (int ts = 0; ts < 8; ++ts) {
            if (ts <= (w | 1)) {
                u32x2 o = (u32x2){0u, 0u};
                if (ts <= w) {
                    const f32x4 acs = *(const f32x4*)(ACs + h8 * 128 + 16 * ts + 4 * fq), dts = *(const f32x4*)(DTs + h8 * 128 + 16 * ts + 4 * fq);
                    float mv[4];
#pragma unroll
                    for (int r = 0; r < 4; ++r) { const bool valid = (ts < w) || (4 * fq + r <= fr); const float e = __expf(fminf(ac_l - acs[r], 0.f)); mv[r] = valid ? cbv[ts][r] * e * dts[r] : 0.f; }
                    o.x = cvt_pk_bf16(mv[0], mv[1]); o.y = cvt_pk_bf16(mv[2], mv[3]);
                }
                *(u32x2*)(Mw + fr * PITCH + 16 * ts + 4 * fq) = o;
            }
        }
        __syncthreads();
        if (h8 < 7) PC_LOADS(h8 + 1);
        f32x4 acc[4];
#pragma unroll
        for (int pt = 0; pt < 4; ++pt) acc[pt] = (f32x4){0.f, 0.f, 0.f, 0.f};
#pragma unroll
        for (int ks = 0; ks < 4; ++ks)
#pragma unroll
            for (int pt = 0; pt < 4; ++pt) { const bf16x8 hf = *(const bf16x8*)(HP + (16 * pt + fr) * PITCH + 32 * ks + 8 * fq);
                acc[pt] = __builtin_amdgcn_mfma_f32_16x16x32_bf16(hf, cfrag[ks], acc[pt], 0, 0, 0); }
        const float el = __expf(ac_l);
#pragma unroll
        for (int pt = 0; pt < 4; ++pt) acc[pt] = acc[pt] * el;
#pragma unroll
        for (int ks = 0; ks < 4; ++ks) {
            if (ks <= (w >> 1)) { const bf16x8 mf = *(const bf16x8*)(Mw + fr * PITCH + 32 * ks + 8 * fq);
#pragma unroll
                for (int pt = 0; pt < 4; ++pt) { const bf16x8 xf = *(const bf16x8*)(XT + (16 * pt + fr) * PITCH + 32 * ks + 8 * fq);
                    acc[pt] = __builtin_amdgcn_mfma_f32_16x16x32_bf16(xf, mf, acc[pt], 0, 0, 0); } } }
        const float Dh = dskip[hg];
#pragma unroll
        for (int pt = 0; pt < 4; ++pt) { const int p0 = 16 * pt + 4 * fq;
            const float z[4] = {bf_lo(zc[pt].x), bf_hi(zc[pt].x), bf_lo(zc[pt].y), bf_hi(zc[pt].y)};
            float yg[4];
#pragma unroll
            for (int r = 0; r < 4; ++r) { const float x = bf2f(XT[(p0 + r) * PITCH + l0 + fr]); yg[r] = (acc[pt][r] + Dh * x) * z[r]; ssq += yg[r] * yg[r]; }
            u32x2 o; o.x = cvt_pk_bf16(yg[0], yg[1]); o.y = cvt_pk_bf16(yg[2], yg[3]);
            *(u32x2*)(YCAT + row * DMIX + hg * 64 + p0) = o; }
    }
#undef PC_LOADS
    ssq += __shfl_xor(ssq, 16); ssq += __shfl_xor(ssq, 32);
    const float rstd = rsqrtf(ssq * (1.f / 512.f) + EPS);
    {
        const f32x4 nw0 = *(const f32x4*)(snw + g * 512 + 8 * lane), nw1 = *(const f32x4*)(snw + g * 512 + 8 * lane + 4);
#pragma unroll 4
        for (int r = 0; r < 16; ++r) {
            const float rs = __shfl(rstd, r);
            u32x4* yp = (u32x4*)(YCAT + (size_t)(R0 + l0 + r) * DMIX + g * 512 + 8 * lane);
            const u32x4 v = *yp; u32x4 o;
            o.x = cvt_pk_bf16(bf_lo(v.x) * rs * nw0[0], bf_hi(v.x) * rs * nw0[1]); o.y = cvt_pk_bf16(bf_lo(v.y) * rs * nw0[2], bf_hi(v.y) * rs * nw0[3]);
            o.z = cvt_pk_bf16(bf_lo(v.z) * rs * nw1[0], bf_hi(v.z) * rs * nw1[1]); o.w = cvt_pk_bf16(bf_lo(v.w) * rs * nw1[2], bf_hi(v.w) * rs * nw1[3]);
            *yp = o;
        }
    }
    __syncthreads();
}

__device__ __forceinline__ void state_scan(const float* S, const float* CDEC, bf16_t* HPB, float* out, int tid, int G) {
    for (int idx = blockIdx.x * 512 + tid; idx < 4 * 32 * 2048; idx += G * 512) {
        const int bh = idx >> 11, e4 = idx & 2047, b = bh >> 5, hg = bh & 31;
        f32x4 s[16]; float d[16];
#pragma unroll
        for (int c = 0; c < 16; ++c) { s[c] = __builtin_nontemporal_load((const f32x4*)(S + ((size_t)((b * 16 + c) * 32 + hg)) * 8192 + 4 * e4)); d[c] = CDEC[(b * 16 + c) * 32 + hg]; }
        f32x4 h = (f32x4){0.f, 0.f, 0.f, 0.f};
#pragma unroll
        for (int c = 0; c < 16; ++c) { u32x2 o; o.x = cvt_pk_bf16(h[0], h[1]); o.y = cvt_pk_bf16(h[2], h[3]);
            *(u32x2*)(HPB + ((size_t)((b * 16 + c) * 32 + hg)) * 8192 + 4 * e4) = o; h = h * d[c] + s[c]; }
        *(f32x4*)(out + O_SSMP + (size_t)bh * 8192 + 4 * e4) = h;
    }
}

constexpr int SB_BS = 0, SB_CS = 4096, SB_RED = 8192, SB_WB = 8448, SB_WSZ = 9216;
__device__ __forceinline__ void sample_unit(int u, const bf16_t* PROJ, const float* DT, const float* alog, const float* cw, const float* cbias, const float* dskip, const float* snw,
                                            const float* state, const float* cstate, float* out, bf16_t* YCAT, unsigned char* lds, int tid, int lane, int w) {
    const int b = u >> 2, g = u & 3, hg = g * 8 + w;
    const size_t prow = (size_t)(MP + b * 8);
    float* BS = (float*)(lds + SB_BS); float* CS = (float*)(lds + SB_CS); float* RED = (float*)(lds + SB_RED); float* Wb = (float*)(lds + SB_WB + w * SB_WSZ);
    const float* st = state + (size_t)(b * 32 + hg) * 8192; float* so = out + O_SSMS + (size_t)(b * 32 + hg) * 8192;
    const int lr8 = lane >> 3, lc8 = (lane & 7) * 4;
    f32x4 sa[8];
#pragma unroll
    for (int i = 0; i < 8; ++i) sa[i] = __builtin_nontemporal_load((const f32x4*)(st + (lr8 + 8 * i) * 128 + lc8));
    if (tid < 256) {
        const int ch = tid < 128 ? 2048 + g * 128 + tid : 2560 + g * 128 + (tid - 128);
        float v[11];
#pragma unroll
        for (int i = 0; i < 3; ++i) v[i] = cstate[(size_t)(b * 3 + i) * 3072 + ch];
#pragma unroll
        for (int t = 0; t < 8; ++t) v[3 + t] = bf2f(PROJ[(prow + t) * LDP + XB + ch]);
        const float w0 = cw[ch], w1 = cw[3072 + ch], w2 = cw[6144 + ch], w3 = cw[9216 + ch], bb = cbias[ch];
        float* dst = tid < 128 ? BS + tid : CS + (tid - 128);
#pragma unroll
        for (int t = 0; t < 8; ++t) dst[t * 128] = silu_f(bb + w0 * v[t] + w1 * v[t + 1] + w2 * v[t + 2] + w3 * v[t + 3]);
#pragma unroll
        for (int i = 0; i < 3; ++i) out[O_CSS + (size_t)(b * 3 + i) * 3072 + ch] = v[8 + i];
    }
    float xv[8], xp[8], dA[8];
    {
        const int ch = hg * 64 + lane;
        float v[11];
#pragma unroll
        for (int i = 0; i < 3; ++i) v[i] = cstate[(size_t)(b * 3 + i) * 3072 + ch];
#pragma unroll
        for (int t = 0; t < 8; ++t) v[3 + t] = bf2f(PROJ[(prow + t) * LDP + XB + ch]);
        const float w0 = cw[ch], w1 = cw[3072 + ch], w2 = cw[6144 + ch], w3 = cw[9216 + ch], bb = cbias[ch];
        const float a = -expf(alog[hg]);
#pragma unroll
        for (int t = 0; t < 8; ++t) { xv[t] = silu_f(bb + w0 * v[t] + w1 * v[t + 1] + w2 * v[t + 2] + w3 * v[t + 3]);
            const float dt = DT[(prow + t) * 32 + hg]; xp[t] = xv[t] * dt; dA[t] = __expf(dt * a); }
#pragma unroll
        for (int i = 0; i < 3; ++i) out[O_CSS + (size_t)(b * 3 + i) * 3072 + ch] = v[8 + i];
    }
    __syncthreads();
    f32x2 yv[8];
#pragma unroll
    for (int t = 0; t < 8; ++t) yv[t] = (f32x2){0.f, 0.f};
#pragma unroll 1
    for (int sc = 0; sc < 4; ++sc) {
#pragma unroll
        for (int i = 0; i < 8; ++i) *(f32x4*)(Wb + (lr8 + 8 * i) * 36 + lc8) = sa[i];
        if (sc < 3) {
#pragma unroll
            for (int i = 0; i < 8; ++i) sa[i] = __builtin_nontemporal_load((const f32x4*)(st + (lr8 + 8 * i) * 128 + (sc + 1) * 32 + lc8));
        }
#pragma unroll
        for (int hf = 0; hf < 2; ++hf) {
            const int ck = 2 * sc + hf;
            f32x4 hq[4];
#pragma unroll
            for (int q = 0; q < 4; ++q) hq[q] = *(const f32x4*)(Wb + lane * 36 + hf * 16 + 4 * q);
#pragma unroll
            for (int t = 0; t < 8; ++t) {
#pragma unroll
                for (int q = 0; q < 4; ++q) { const f32x4 Bq = *(const f32x4*)(BS + t * 128 + ck * 16 + 4 * q), Cq = *(const f32x4*)(CS + t * 128 + ck * 16 + 4 * q);
                    hq[q] = hq[q] * dA[t] + Bq * xp[t];
                    yv[t] = yv[t] + (f32x2){hq[q][0], hq[q][1]} * (f32x2){Cq[0], Cq[1]} + (f32x2){hq[q][2], hq[q][3]} * (f32x2){Cq[2], Cq[3]}; }
                __builtin_amdgcn_sched_barrier(0);
            }
#pragma unroll
            for (int q = 0; q < 4; ++q) *(f32x4*)(Wb + lane * 36 + hf * 16 + 4 * q) = hq[q];
        }
#pragma unroll
        for (int i = 0; i < 8; ++i) { const f32x4 v = *(const f32x4*)(Wb + (lr8 + 8 * i) * 36 + lc8); __builtin_nontemporal_store(v, (f32x4*)(so + (lr8 + 8 * i) * 128 + sc * 32 + lc8)); }
    }
    {
        const int ch = g * 512 + w * 64 + lane; const float Dh = dskip[hg], nw = snw[ch];
        float yg[8];
#pragma unroll
        for (int t = 0; t < 8; ++t) { const float z = bf2f(PROJ[(prow + t) * LDP + ch]); const float y = (yv[t][0] + yv[t][1]) + Dh * xv[t]; yg[t] = y * z;
            const float sq = wave_sum(yg[t] * yg[t]); if (lane == 0) RED[t * 8 + w] = sq; }
        __syncthreads();
#pragma unroll
        for (int t = 0; t < 8; ++t) { float tot = 0.f;
#pragma unroll
            for (int k = 0; k < 8; ++k) tot += RED[t * 8 + k];
            const float rstd = rsqrtf(tot * (1.f / 512.f) + EPS);
            YCAT[(prow + t) * DMIX + ch] = (bf16_t)(cvt_pk_bf16(yg[t] * rstd * nw, 0.f) & 0xffffu); }
    }
    __syncthreads();
}

__device__ __forceinline__ void unpack8(const u32x4 p, float (&f)[8]) {
#pragma unroll
    for (int q = 0; q < 4; ++q) { f[2 * q] = bf_lo(p[q]); f[2 * q + 1] = bf_hi(p[q]); }
}
__device__ __forceinline__ void short_conv(const bf16_t* PROJ, const float* csw, const float* cshort, float* out, bf16_t* YCAT, int tid, int G) {
    for (int task = blockIdx.x * 512 + tid; task < 1152 * 256; task += G * 512) {
        const int rb = task >> 8, cgp = task & 255, c0 = 8 * cgp; const size_t r0 = (size_t)rb * 8;
        u32x4 ur[8], gr[8];
#pragma unroll
        for (int t = 0; t < 8; ++t) { ur[t] = __builtin_nontemporal_load((const u32x4*)(PROJ + (r0 + t) * LDP + UC + c0)); gr[t] = __builtin_nontemporal_load((const u32x4*)(PROJ + (r0 + t) * LDP + GC + c0)); }
        float w[3][8];
#pragma unroll
        for (int i = 0; i < 3; ++i) { const f32x4 a = *(const f32x4*)(csw + i * 2048 + c0), bq = *(const f32x4*)(csw + i * 2048 + c0 + 4);
            w[i][0] = a[0]; w[i][1] = a[1]; w[i][2] = a[2]; w[i][3] = a[3]; w[i][4] = bq[0]; w[i][5] = bq[1]; w[i][6] = bq[2]; w[i][7] = bq[3]; }
        float u2[8], u1[8];
        if (rb >= 1024) { const int b = rb - 1024;
#pragma unroll
            for (int e = 0; e < 8; ++e) { u2[e] = cshort[(size_t)(b * 2 + 0) * 2048 + c0 + e]; u1[e] = cshort[(size_t)(b * 2 + 1) * 2048 + c0 + e]; }
        } else if ((rb & 255) == 0) {
#pragma unroll
            for (int e = 0; e < 8; ++e) { u2[e] = 0.f; u1[e] = 0.f; }
        } else {
            unpack8(*(const u32x4*)(PROJ + (r0 - 2) * LDP + UC + c0), u2); unpack8(*(const u32x4*)(PROJ + (r0 - 1) * LDP + UC + c0), u1);
        }
#pragma unroll
        for (int t = 0; t < 8; ++t) {
            float uu[8], gz[8], y[8];
            unpack8(ur[t], uu); unpack8(gr[t], gz);
#pragma unroll
            for (int e = 0; e < 8; ++e) y[e] = gz[e] * (w[0][e] * u2[e] + w[1][e] * u1[e] + w[2][e] * uu[e]);
            u32x4 o; o.x = cvt_pk_bf16(y[0], y[1]); o.y = cvt_pk_bf16(y[2], y[3]); o.z = cvt_pk_bf16(y[4], y[5]); o.w = cvt_pk_bf16(y[6], y[7]);
            *(u32x4*)(YCAT + (r0 + t) * DMIX + 2048 + c0) = o;
            if (t >= 6) {
                float* dst = nullptr;
                if (rb >= 1024) dst = out + O_CSHS + (size_t)((rb - 1024) * 2 + (t - 6)) * 2048 + c0;
                else if ((rb & 255) == 255) dst = out + O_CSHP + (size_t)((rb >> 8) * 2 + (t - 6)) * 2048 + c0;
                if (dst) { *(f32x4*)dst = (f32x4){uu[0], uu[1], uu[2], uu[3]}; *(f32x4*)(dst + 4) = (f32x4){uu[4], uu[5], uu[6], uu[7]}; }
            }
#pragma unroll
            for (int e = 0; e < 8; ++e) { u2[e] = u1[e]; u1[e] = uu[e]; }
        }
    }
}

#define XB_TMO      128
#define XB_XCNT(j)  (256  + 64 * (j))
#define XB_XSUB(j)  (1280 + 64 * (j))
#define XB_XGEN(j)  (2304 + 64 * (j))
#define XB_TOP      3328
#define XB_TOPGEN   3392
#define XCD_BAR_WORDS 3456
#define XB_SPIN_CAP (1u << 22)
__device__ __forceinline__ unsigned xb_ld(unsigned* p)              { return __hip_atomic_load(p, __ATOMIC_RELAXED, __HIP_MEMORY_SCOPE_AGENT); }
__device__ __forceinline__ unsigned xb_add(unsigned* p, unsigned v) { return __hip_atomic_fetch_add(p, v, __ATOMIC_RELAXED, __HIP_MEMORY_SCOPE_AGENT); }
__device__ __forceinline__ unsigned xb_xcc_id() { return (unsigned)__builtin_amdgcn_s_getreg((3 << 11) | 20) & 0xFu; }
#define XB_SPIN(cond, bar) do { unsigned _sp = 0; while (cond) { __builtin_amdgcn_s_sleep(1); \
    if ((++_sp & 255u) == 0u) { if (xb_ld(&(bar)[XB_TMO])) break; if (_sp > XB_SPIN_CAP) { atomicAdd(&(bar)[XB_TMO], 1u); break; } } } } while (0)
struct XcdBarrier { unsigned* bar; unsigned x; volatile LAS unsigned* st; };
__device__ __forceinline__ XcdBarrier xcd_barrier_post(unsigned* bar, volatile LAS unsigned* st) {
    XcdBarrier b; b.bar = bar; b.x = xb_xcc_id(); b.st = st;
    if (threadIdx.x == 0) (void)xb_add(&bar[XB_XCNT(b.x)], 1u);
    return b;
}
__device__ __forceinline__ void xcd_barrier_complete(unsigned* bar, unsigned x, unsigned& nloc, unsigned& nx) {
    const unsigned G = gridDim.x * gridDim.y * gridDim.z;
    unsigned sum, cnt, mine, sp = 0u;
    for (;;) {
        sum = 0u; cnt = 0u; mine = 0u;
#pragma unroll
        for (unsigned j = 0; j < 16; ++j) { const unsigned c = xb_ld(&bar[XB_XCNT(j)]); sum += c; cnt += (c > 0u) ? 1u : 0u; mine = (j == x) ? c : mine; }
        if (sum == G) break;
        __builtin_amdgcn_s_sleep(1);
        if ((++sp & 255u) == 0u) { if (xb_ld(&bar[XB_TMO])) break; if (sp > XB_SPIN_CAP) { atomicAdd(&bar[XB_TMO], 1u); break; } }
    }
    nloc = mine > 0u ? mine : 1u; nx = cnt > 0u ? cnt : 1u;
}
__device__ __forceinline__ void xcd_barrier(const XcdBarrier& b) {
    asm volatile("s_waitcnt vmcnt(0)" ::: "memory");
    __syncthreads();
    if (threadIdx.x == 0) {
        unsigned* bar = b.bar;
        __builtin_amdgcn_s_waitcnt(0);
        unsigned nloc = b.st[0], nx = b.st[1];
        if (nloc == 0u) { xcd_barrier_complete(bar, b.x, nloc, nx); b.st[0] = nloc; b.st[1] = nx; }
        const unsigned old = xb_add(&bar[XB_XSUB(b.x)], 1u);
        const unsigned gen = old / nloc;
        if (old + 1u == (gen + 1u) * nloc) {
            __builtin_amdgcn_fence(__ATOMIC_RELEASE, "agent");
            asm volatile("s_waitcnt vmcnt(0)" ::: "memory");
            const unsigned og = xb_add(&bar[XB_TOP], 1u);
            const unsigned tg = og / nx;
            if (og + 1u == (tg + 1u) * nx) xb_add(&bar[XB_TOPGEN], 1u);
            else XB_SPIN(xb_ld(&bar[XB_TOPGEN]) == tg, bar);
            __builtin_amdgcn_fence(__ATOMIC_ACQUIRE, "agent");
            xb_add(&bar[XB_XGEN(b.x)], 1u);
            asm volatile("s_waitcnt vmcnt(0)" ::: "memory");
        } else {
            XB_SPIN(xb_ld(&bar[XB_XGEN(b.x)]) == gen, bar);
            __builtin_amdgcn_fence(__ATOMIC_ACQUIRE, "agent");
            asm volatile("s_waitcnt vmcnt(0)" ::: "memory");
        }
    }
    __syncthreads();
}

struct Args { const float* in[16]; float* out; unsigned char* ws; };

__global__ void __launch_bounds__(512, 2) hymba_fwd(Args a) {
    extern __shared__ __attribute__((aligned(16))) unsigned char lds[];
    cg::grid_group grid = cg::this_grid();
    const int tid = threadIdx.x, lane = tid & 63, wave = __builtin_amdgcn_readfirstlane(tid >> 6), G = gridDim.x;
    typedef const __attribute__((address_space(4))) volatile unsigned long long* kargp_t;
#define KARG(i) ((const float*)(((kargp_t)__builtin_amdgcn_kernarg_segment_ptr())[(i)]))
#define KOUT ((float*)(((kargp_t)__builtin_amdgcn_kernarg_segment_ptr())[16]))
#define KWS ((unsigned char*)(((kargp_t)__builtin_amdgcn_kernarg_segment_ptr())[17]))
#define WSP(T, off) ((T*)(KWS + (off)))
    if (tid < 64) ((LAS unsigned*)((LAS unsigned char*)lds + LDS_ST))[tid] = 0u;
    __syncthreads();
    const XcdBarrier xbar = xcd_barrier_post((unsigned*)(KWS + WS_CTL), (volatile LAS unsigned*)((LAS unsigned char*)lds + LDS_ST));
    phase0(KARG(0), KARG(1), KARG(5), KARG(6), KARG(14), WSP(bf16_t, WS_WIN), WSP(bf16_t, WS_WOUT), WSP(bf16_t, WS_H), lds, tid, lane, wave, G);
    xcd_barrier(xbar);
    { pg8::Gemm g{WSP(bf16_t, WS_H), WSP(bf16_t, WS_WIN), MT, N1, DM, DM}; pg8::StaticOrder So; So.init(MT, N1, G, (int)blockIdx.x); pg8::Epi1 E{WSP(bf16_t, WS_PROJ), WSP(float, WS_DT), KARG(9)};
      pg8::gemm_phase<pg8::Epi1, pg8::StaticOrder>((LAS unsigned char*)lds, g, So, E); }
    {
      const int nfull = (MT / 256) * (N1 / 256) % G, nidle = G - nfull;
      if (nfull == 0) transpose_items((int)blockIdx.x, T_IN, T_ALL, G, KARG(6), KARG(14), WSP(bf16_t, WS_WIN), WSP(bf16_t, WS_WOUT), (float*)lds, tid);
      else if ((int)blockIdx.x >= nfull) transpose_items((int)blockIdx.x - nfull, T_IN, T_ALL, nidle, KARG(6), KARG(14), WSP(bf16_t, WS_WIN), WSP(bf16_t, WS_WOUT), (float*)lds, tid); }
    grid.sync();
    { const bf16_t* PROJ = WSP(bf16_t, WS_PROJ); float* out = KOUT;
      for (int u = blockIdx.x; u < 256; u += G) ssd_passA(u, PROJ, WSP(float, WS_DT), KARG(10), KARG(7), KARG(8), WSP(float, WS_S), WSP(float, WS_CDEC), WSP(bf16_t, WS_XTG), lds, tid, lane, wave);
      short_conv(PROJ, KARG(13), KARG(4), out, WSP(bf16_t, WS_YCAT), tid, G);
      for (int idx = blockIdx.x * 512 + tid; idx < 4 * 3 * 3072; idx += G * 512) { const int b = idx / 9216, r = (idx / 3072) % 3, ch = idx % 3072;
          out[O_CSP + idx] = bf2f(PROJ[(size_t)(b * 2048 + 2045 + r) * LDP + XB + ch]); } }
    xcd_barrier(xbar);
    state_scan(WSP(float, WS_S), WSP(float, WS_CDEC), WSP(bf16_t, WS_HPB), KOUT, tid, G);
    for (int u = blockIdx.x; u < 512; u += G) sample_unit(u, WSP(bf16_t, WS_PROJ), WSP(float, WS_DT), KARG(10), KARG(7), KARG(8), KARG(11), KARG(12), KARG(2), KARG(3), KOUT, WSP(bf16_t, WS_YCAT), lds, tid, lane, wave);
    xcd_barrier(xbar);
    for (int u = blockIdx.x; u < 256; u += G) ssd_passC(u, WSP(bf16_t, WS_PROJ), WSP(float, WS_DT), KARG(10), KARG(7), KARG(8), KARG(11), KARG(12), WSP(bf16_t, WS_XTG), WSP(bf16_t, WS_HPB), WSP(bf16_t, WS_YCAT), lds, tid, lane, wave);
    xcd_barrier(xbar);
    const bool fusedn = (G == 256);
    if (fusedn) { pg8::Gemm g{WSP(bf16_t, WS_YCAT), WSP(bf16_t, WS_WOUT), MP, DM, DMIX, DMIX}; pg8::StaticOrder So; So.init(MP, DM, G, (int)blockIdx.x);
      pg8::Epi2f E{KARG(0), KOUT, KARG(15), WSP(float, WS_SSQ), (unsigned*)(KWS + WS_CTL) + 4096, (LAS unsigned char*)lds};
      pg8::gemm_phase<pg8::Epi2f, pg8::StaticOrder>((LAS unsigned char*)lds, g, So, E); }
    else { pg8::Gemm g{WSP(bf16_t, WS_YCAT), WSP(bf16_t, WS_WOUT), MP, DM, DMIX, DMIX}; pg8::StaticOrder So; So.init(MP, DM, G, (int)blockIdx.x); pg8::Epi2 E{KARG(0), KOUT};
      pg8::gemm_phase<pg8::Epi2, pg8::StaticOrder>((LAS unsigned char*)lds, g, So, E); }
    for (int ks = (int)(blockIdx.x & 7); ks < 8; ks += 8) {
      pg8::Gemm g{WSP(bf16_t, WS_YCAT) + ks * 512, WSP(bf16_t, WS_WOUT) + ks * 512, MT, DM, 512, DMIX}; pg8::SplitOrder So{G, (int)blockIdx.x}; pg8::Epi2s E{WSP(bf16_t, WS_PART) + (size_t)ks * MS * DM};
      pg8::gemm_phase<pg8::Epi2s, pg8::SplitOrder>((LAS unsigned char*)lds, g, So, E); }
    xcd_barrier(xbar);
    { const int gw = blockIdx.x * 8 + wave, NGW = G * 8; const float* fnw = KARG(15); float* out = KOUT; const float* xsam = KARG(1); const bf16_t* part = WSP(bf16_t, WS_PART);
      f32x4 nv[8];
#define P4_LOAD(mm) do { if ((mm) < MP) { const f32x4* _o = (const f32x4*)(out + (size_t)(mm) * DM) + lane; _Pragma("unroll") for (int j = 0; j < 8; ++j) nv[j] = _o[64 * j]; } \
          else { const f32x4* _x = (const f32x4*)(xsam + (size_t)((mm) - MP) * DM) + lane; const u32x2* _p = (const u32x2*)(part + (size_t)((mm) - MP) * DM) + lane; \
              _Pragma("unroll") for (int j = 0; j < 8; ++j) nv[j] = _x[64 * j]; \
              _Pragma("unroll") for (int ks = 0; ks < 8; ++ks) _Pragma("unroll") for (int j = 0; j < 8; ++j) { const u32x2 _v = _p[(size_t)ks * (MS * DM / 4) + 64 * j]; \
                  nv[j] = nv[j] + (f32x4){bf_lo(_v.x), bf_hi(_v.x), bf_lo(_v.y), bf_hi(_v.y)}; } } } while (0)
      const int m0 = (fusedn ? MP : 0) + gw;
      if (m0 < MT) P4_LOAD(m0);
      for (int m = m0; m < MT; m += NGW) {
          f32x4 v[8]; float ss = 0.f;
#pragma unroll
          for (int j = 0; j < 8; ++j) { v[j] = nv[j]; ss += (v[j][0] * v[j][0] + v[j][1] * v[j][1]) + (v[j][2] * v[j][2] + v[j][3] * v[j][3]); }
          const int mn = m + NGW;
          if (mn < MT) P4_LOAD(mn);
          const float rs = rsqrtf(wave_sum(ss) * (1.f / DM) + EPS);
          f32x4* o = (f32x4*)(out + (size_t)m * DM) + lane;
#pragma unroll
          for (int j = 0; j < 8; ++j) { const f32x4 w = ((const f32x4*)fnw)[64 * j + lane]; o[64 * j] = v[j] * rs * w; }
      }
#undef P4_LOAD
    }
}

extern "C" void kernel_launch(void* const* d_in, const int* in_sizes, int n_in, void* d_out, int out_size, void* d_ws, size_t ws_size, hipStream_t stream) {
    static int grid = 0;
    if (grid == 0) {
        if (n_in != 16 || (size_t)out_size != O_END || ws_size < WS_END) { fprintf(stderr, "kernel_launch: unexpected shapes (n_in %d, out %d, ws %zu)\n", n_in, out_size, ws_size); grid = -1; return; }
        int dev = 0, cus = 0, per_cu = 0;
        hipGetDevice(&dev); hipDeviceGetAttribute(&cus, hipDeviceAttributeMultiprocessorCount, dev);
        hipFuncSetAttribute((const void*)hymba_fwd, hipFuncAttributeMaxDynamicSharedMemorySize, LDS_BYTES);
        hipOccupancyMaxActiveBlocksPerMultiprocessor(&per_cu, (const void*)hymba_fwd, 512, LDS_BYTES);
        if (per_cu < 1) { fprintf(stderr, "kernel_launch: occupancy query says %d blocks/CU\n", per_cu); per_cu = 1; }
        grid = cus * 1;
        (void)hipGetLastError();
    }
    if (grid < 0) return;
    if (hipMemsetAsync((char*)d_ws + WS_CTL, 0, 32768, stream) != hipSuccess) { fprintf(stderr, "kernel_launch: memset of the barrier words failed\n"); return; }
    Args a{};
    for (int i = 0; i < 16; ++i) a.in[i] = (const float*)d_in[i];
    a.out = (float*)d_out; a.ws = (unsigned char*)d_ws;
    void* args[] = {&a};
    hipError_t e = hipLaunchCooperativeKernel((const void*)hymba_fwd, dim3(grid), dim3(512), args, LDS_BYTES, stream);
    if (e != hipSuccess) fprintf(stderr, "cooperative launch failed: %s (grid %d)\n", hipGetErrorString(e), grid);
}
```

```cpp
#include <hip/hip_runtime.h>
#include <hip/hip_cooperative_groups.h>
#include <cstdio>
#include <cstdint>
namespace cg = cooperative_groups;

#define LAS __attribute__((address_space(3)))
typedef unsigned short bf16_t;
typedef short bf16x8 __attribute__((ext_vector_type(8)));
typedef float f32x4 __attribute__((ext_vector_type(4)));
typedef float f32x2 __attribute__((ext_vector_type(2)));
typedef unsigned u32x4 __attribute__((ext_vector_type(4)));
typedef unsigned u32x2 __attribute__((ext_vector_type(2)));

constexpr int DM = 2048, MP = 8192, MS = 1024, MT = 9216;
constexpr int DIN = 13344;
constexpr int LDP = 13312;
constexpr int N1 = 13568;
constexpr int XB = 2048;
constexpr int UC = 5120, GC = 7168;
constexpr int DMIX = 4096;
constexpr float EPS = 1e-6f;
constexpr size_t O_YP = 0, O_YS = 16777216, O_SSMP = 18874368, O_CSP = 19922944, O_CSHP = 19959808,
                 O_SSMS = 19976192, O_CSS = 53530624, O_CSHS = 54710272, O_END = 55234560;
constexpr size_t MiB = 1u << 20;
constexpr size_t WS_WIN = 0, WS_WOUT = 54 * MiB, WS_H = 70 * MiB, WS_PROJ = 106 * MiB, WS_DT = 340 * MiB,
                 WS_YCAT = 342 * MiB, WS_S = 414 * MiB, WS_CDEC = 478 * MiB, WS_SSQ = 479 * MiB, WS_CTL = 481 * MiB, WS_END = 482 * MiB;
constexpr size_t WS_XTG = WS_WIN, WS_HPB = WS_H, WS_PART = WS_PROJ;
constexpr int LDS_BYTES = 147456 + 256, LDS_ST = 147456;

__device__ __forceinline__ unsigned cvt_pk_bf16(float lo, float hi) { unsigned r; asm volatile("v_cvt_pk_bf16_f32 %0, %1, %2" : "=v"(r) : "v"(lo), "v"(hi)); return r; }
__device__ __forceinline__ float bf_lo(unsigned v) { return __uint_as_float(v << 16); }
__device__ __forceinline__ float bf_hi(unsigned v) { return __uint_as_float(v & 0xffff0000u); }
__device__ __forceinline__ float bf2f(bf16_t v) { return __uint_as_float((unsigned)v << 16); }
__device__ __forceinline__ float silu_f(float x) { return x * __builtin_amdgcn_rcpf(1.0f + __expf(-x)); }
__device__ __forceinline__ float wave_sum(float v) {
#pragma unroll
    for (int o = 1; o < 64; o <<= 1) v += __shfl_xor(v, o);
    return v;
}
template <int CTRL> __device__ __forceinline__ float dpp_get(float v) { return __int_as_float(__builtin_amdgcn_update_dpp(0, __float_as_int(v), CTRL, 0xF, 0xF, true)); }
__device__ __forceinline__ float reduce32(float v) {
    v += dpp_get<0xB1>(v);
    v += dpp_get<0x4E>(v);
    v += dpp_get<0x141>(v);
    v += dpp_get<0x140>(v);
    v += __shfl_xor(v, 16);
    return v;
}
#define LDS_WAIT() asm volatile("s_waitcnt lgkmcnt(0)" ::: "memory")

namespace pg8 {
#define PG8_LAS __attribute__((address_space(3)))
constexpr int BM = 256, BK = 64, HALF = 128, HTB = HALF * BK * 2, NXCD = 8, WGM = 8;
__host__ __device__ __forceinline__ int lds_byte(int r, int c) { const int st = (r >> 4) * 2 + (c >> 5), rr = r & 15, cc = c & 31, ob = rr * 64 + cc * 2; return st * 1024 + (ob ^ (((ob >> 9) & 1) << 5)); }
__host__ __device__ __forceinline__ void stage_rc(int b, int& R, int& C) { const int st = b / 1024, sb = b % 1024, swz = sb ^ (((sb >> 9) & 1) << 5); R = (st >> 1) * 16 + swz / 64; C = (st & 1) * 32 + (swz % 64) / 2; }
__host__ __device__ __forceinline__ int perm32(int rho) { const int n = rho >> 4, i = rho & 15; return 8 * (i >> 2) + 4 * n + (i & 3); }
struct Unit { int pm, pn; };
struct Gemm { const bf16_t* A; const bf16_t* Bt; int M, N, K, ld; };
struct StaticOrder {
    int nM, nN, nwg, G, c;
    __host__ __device__ void init(int M, int N, int G_, int c_) { nM = M / BM; nN = N / BM; nwg = nM * nN; G = G_; c = c_; }
    __host__ __device__ bool next(int i, Unit& u) const {
        const long L = (long)i * G + c; if (L >= nwg) return false;
        int wgid = (int)L; { const int q = nwg / NXCD, r = nwg % NXCD, xcd = wgid % NXCD, off = wgid / NXCD; wgid = (xcd < r ? xcd * (q + 1) : r * (q + 1) + (xcd - r) * q) + off; }
        const int nig = WGM * nN, gid = wgid / nig, fm = gid * WGM, gsz = (nM - fm) < WGM ? (nM - fm) : WGM;
        u.pm = fm + ((wgid % nig) % gsz); u.pn = (wgid % nig) / gsz; return true;
    }
};

struct SplitOrder {
    int G, c;
    __host__ __device__ bool next(int i, Unit& u) const { const long L = (long)i * G + c; if (L >= 256) return false; const int t = (int)L >> 3; u.pm = 32 + (t >> 3); u.pn = t & 7; return true; }
};
template <class Epi, class Sched>
__device__ __forceinline__ void gemm_phase(PG8_LAS unsigned char* lds, const Gemm g, const Sched& S, const Epi& E) {
    int tid = threadIdx.x; asm volatile("" : "+v"(tid));
    const int wid = __builtin_amdgcn_readfirstlane(tid >> 6), lane = tid & 63, wr = wid >> 2, wc = wid & 3, fr = lane & 15, fq = lane >> 4;
    const int K = g.ld, nt = g.K / BK;
    unsigned voffA[2], voffB[2];
#pragma unroll
    for (int i = 0; i < 2; ++i) { int R, C; stage_rc(tid * 16 + i * 8192, R, C); const int Rb = (R & ~31) + perm32(R & 31);
        voffA[i] = (unsigned)(R * K + C) * 2u; voffB[i] = (unsigned)(Rb * K + C) * 2u; }
    const size_t kstep = (size_t)(BK * 2);
    const size_t hstep = (size_t)HALF * K * 2;
    const size_t tstep = 2 * hstep;
    const unsigned ldsw = (unsigned)wid * 1024u;
    const int aoff = lds_byte(wr * 64 + fr, fq * 8), boff = lds_byte(wc * 32 + fr, fq * 8);
#define PG8_SA(b, h) (((b) * 2 + (h)) * HTB)
#define PG8_SB(b, h) ((4 + (b) * 2 + (h)) * HTB)
#define PG8_STAGE(bufoff, gbase, voff) do { _Pragma("unroll") for (int _i = 0; _i < 2; ++_i) \
        __builtin_amdgcn_global_load_lds((const unsigned*)((const char*)(gbase) + (voff)[_i]), (PG8_LAS unsigned*)(lds + (bufoff) + ldsw + _i * 8192), 16, 0, 0); } while (0)
#define PG8_LDA(dst, b, h) do { _Pragma("unroll") for (int m = 0; m < 4; ++m) _Pragma("unroll") for (int k = 0; k < 2; ++k) dst[m][k] = *(const PG8_LAS bf16x8*)(lds + PG8_SA(b, h) + aoff + m * 2048 + k * 1024); } while (0)
#define PG8_LDB(dst, b, h) do { _Pragma("unroll") for (int n = 0; n < 2; ++n) _Pragma("unroll") for (int k = 0; k < 2; ++k) dst[n][k] = *(const PG8_LAS bf16x8*)(lds + PG8_SB(b, h) + boff + n * 2048 + k * 1024); } while (0)
#define PG8_MMA(ai, bj, At, Bt) do { __builtin_amdgcn_s_setprio(1); _Pragma("unroll") for (int m = 0; m < 4; ++m) _Pragma("unroll") for (int n = 0; n < 2; ++n) _Pragma("unroll") for (int k = 0; k < 2; ++k) \
        acc[ai][bj][m][n] = __builtin_amdgcn_mfma_f32_16x16x32_bf16(Bt[n][k], At[m][k], acc[ai][bj][m][n], 0, 0, 0); __builtin_amdgcn_s_setprio(0); } while (0)
#define PG8_WAIT_V(n) asm volatile("s_waitcnt vmcnt(" #n ")" ::: "memory")
#define PG8_WAIT_L(n) asm volatile("s_waitcnt lgkmcnt(" #n ")" ::: "memory")
#define PG8_BAR __builtin_amdgcn_s_barrier()
#define PG8_SCHED __builtin_amdgcn_sched_barrier(0)
    Unit cur, nxt; int ui = 0;
    if (!S.next(0, cur)) return;
    f32x4 acc[2][2][4][2];
#pragma unroll
    for (int a = 0; a < 2; ++a)
#pragma unroll
        for (int b = 0; b < 2; ++b)
#pragma unroll
            for (int m = 0; m < 4; ++m)
#pragma unroll
                for (int n = 0; n < 2; ++n) acc[a][b][m][n] = (f32x4){0.f, 0.f, 0.f, 0.f};
    bf16x8 At[4][2], B0[2][2], B1[2][2];
    const char* cA = (const char*)g.A + (size_t)cur.pm * tstep; const char* cB = (const char*)g.Bt + (size_t)cur.pn * tstep;
    PG8_STAGE(PG8_SB(0, 0), cB, voffB); PG8_STAGE(PG8_SB(0, 1), cB + hstep, voffB); PG8_STAGE(PG8_SA(0, 0), cA, voffA); PG8_STAGE(PG8_SA(0, 1), cA + hstep, voffA);
    if (wr == 1) PG8_BAR;
    PG8_WAIT_V(2); PG8_BAR;
    PG8_STAGE(PG8_SB(1, 0), cB + kstep, voffB); PG8_STAGE(PG8_SA(1, 0), cA + kstep, voffA); PG8_STAGE(PG8_SB(1, 1), cB + hstep + kstep, voffB);
    PG8_WAIT_V(6); PG8_BAR;
    for (;;) {
        const bool has_next = S.next(ui + 1, nxt);
        const char* nA = has_next ? (const char*)g.A + (size_t)nxt.pm * tstep : cA; const char* nB = has_next ? (const char*)g.Bt + (size_t)nxt.pn * tstep : cB;
        for (int t = 0; t < nt; t += 2) {
            const bool last = (t == nt - 2);
            const char* a1 = cA + (size_t)(t + 1) * kstep;
            const char* a2 = last ? nA : cA + (size_t)(t + 2) * kstep; const char* b2 = last ? nB : cB + (size_t)(t + 2) * kstep;
            const char* a3 = a2 + kstep; const char* b3 = b2 + kstep;
            PG8_LDB(B0, 0, 0); PG8_LDB(B1, 0, 1); PG8_SCHED; PG8_LDA(At, 0, 0); PG8_STAGE(PG8_SA(1, 1), a1 + hstep, voffA);
            PG8_WAIT_V(8); PG8_WAIT_L(0); PG8_BAR; PG8_MMA(0, 0, At, B0); PG8_MMA(0, 1, At, B1); PG8_BAR; PG8_SCHED;
            PG8_LDA(At, 0, 1); PG8_STAGE(PG8_SB(0, 0), b2, voffB); PG8_STAGE(PG8_SB(0, 1), b2 + hstep, voffB); PG8_STAGE(PG8_SA(0, 0), a2, voffA);
            PG8_WAIT_V(8); PG8_WAIT_L(0); PG8_BAR; PG8_MMA(1, 0, At, B0); PG8_MMA(1, 1, At, B1); PG8_BAR; PG8_SCHED;
            PG8_LDB(B0, 1, 0); PG8_LDB(B1, 1, 1); PG8_SCHED; PG8_LDA(At, 1, 0); PG8_STAGE(PG8_SA(0, 1), a2 + hstep, voffA);
            PG8_WAIT_V(8); PG8_WAIT_L(0); PG8_BAR; PG8_MMA(0, 0, At, B0); PG8_MMA(0, 1, At, B1); PG8_BAR; PG8_SCHED;
            PG8_LDA(At, 1, 1); PG8_STAGE(PG8_SB(1, 0), b3, voffB); PG8_STAGE(PG8_SB(1, 1), b3 + hstep, voffB); PG8_STAGE(PG8_SA(1, 0), a3, voffA);
            PG8_WAIT_V(8); PG8_WAIT_L(0); PG8_BAR; PG8_MMA(1, 0, At, B0); PG8_MMA(1, 1, At, B1); PG8_BAR; PG8_SCHED;
        }
        if (wr == 0) PG8_BAR;
        E(acc, cur, wr, wc, fr, fq);
        if (!has_next) break;
#pragma unroll
        for (int a = 0; a < 2; ++a)
#pragma unroll
            for (int b = 0; b < 2; ++b)
#pragma unroll
                for (int m = 0; m < 4; ++m)
#pragma unroll
                    for (int n = 0; n < 2; ++n) acc[a][b][m][n] = (f32x4){0.f, 0.f, 0.f, 0.f};
        cur = nxt; cA = nA; cB = nB; ++ui;
        if (wr == 1) PG8_BAR;
    }
    PG8_WAIT_V(0);
    PG8_BAR;
#undef PG8_SA
#undef PG8_SB
#undef PG8_STAGE
#undef PG8_LDA
#undef PG8_LDB
#undef PG8_MMA
#undef PG8_WAIT_V
#undef PG8_WAIT_L
#undef PG8_BAR
#undef PG8_SCHED
}

struct Epi1 {
    bf16_t* P; float* DT; const float* dt_bias;
    __device__ __forceinline__ void operator()(const f32x4 (&acc)[2][2][4][2], const Unit& u, int wr, int wc, int fr, int fq) const {
        const int row0 = u.pm * BM + wr * 64 + fr;
        if (u.pn < 20) {
            const int col0 = u.pn * BM + wc * 32 + 8 * fq;
#pragma unroll
            for (int ai = 0; ai < 2; ++ai)
#pragma unroll
                for (int m = 0; m < 4; ++m) { bf16_t* rowp = P + (size_t)(row0 + ai * HALF + m * 16) * LDP + col0;
#pragma unroll
                    for (int bj = 0; bj < 2; ++bj) { f32x4 v0 = acc[ai][bj][m][0], v1 = acc[ai][bj][m][1];
                        if (u.pn < 8) {
#pragma unroll
                            for (int e = 0; e < 4; ++e) { v0[e] = silu_f(v0[e]); v1[e] = silu_f(v1[e]); } }
                        u32x4 w; w.x = cvt_pk_bf16(v0[0], v0[1]); w.y = cvt_pk_bf16(v0[2], v0[3]); w.z = cvt_pk_bf16(v1[0], v1[1]); w.w = cvt_pk_bf16(v1[2], v1[3]);
                        *(u32x4*)(rowp + bj * HALF) = w; } }
        } else if (u.pn < 52) {
            const int ch0 = (u.pn - 20) * 64 + 16 * wc + 4 * fq;
#pragma unroll
            for (int ai = 0; ai < 2; ++ai)
#pragma unroll
                for (int m = 0; m < 4; ++m) { bf16_t* rowp = P + (size_t)(row0 + ai * HALF + m * 16) * LDP + ch0;
                    const f32x4 z = acc[ai][0][m][0], b = acc[ai][0][m][1], c = acc[ai][1][m][0], v = acc[ai][1][m][1];
                    const f32x4 uu = c * v; f32x4 gz;
#pragma unroll
                    for (int e = 0; e < 4; ++e) gz[e] = b[e] * silu_f(z[e]);
                    u32x2 wu, wg; wu.x = cvt_pk_bf16(uu[0], uu[1]); wu.y = cvt_pk_bf16(uu[2], uu[3]); wg.x = cvt_pk_bf16(gz[0], gz[1]); wg.y = cvt_pk_bf16(gz[2], gz[3]);
                    *(u32x2*)(rowp + UC) = wu; *(u32x2*)(rowp + GC) = wg; }
        } else if (wc == 0) {
            f32x4 bv[2];
#pragma unroll
            for (int n = 0; n < 2; ++n) bv[n] = *(const f32x4*)(dt_bias + 8 * fq + 4 * n);
#pragma unroll
            for (int ai = 0; ai < 2; ++ai)
#pragma unroll
                for (int m = 0; m < 4; ++m) { float* rowp = DT + (size_t)(row0 + ai * HALF + m * 16) * 32 + 8 * fq;
#pragma unroll
                    for (int n = 0; n < 2; ++n) { f32x4 v = acc[ai][0][m][n] + bv[n], o;
#pragma unroll
                        for (int e = 0; e < 4; ++e) o[e] = v[e] > 20.f ? v[e] : log1pf(__expf(v[e]));
                        *(f32x4*)(rowp + 4 * n) = o; } }
        }
    }
};
struct Epi2 {
    const float* XP; float* OUT;
    __device__ __forceinline__ void operator()(const f32x4 (&acc)[2][2][4][2], const Unit& u, int wr, int wc, int fr, int fq) const {
        const int row0 = u.pm * BM + wr * 64 + fr, col0 = u.pn * BM + wc * 32 + 8 * fq;
#pragma unroll
        for (int ai = 0; ai < 2; ++ai)
#pragma unroll
            for (int m = 0; m < 4; ++m) { const int r = row0 + ai * HALF + m * 16;
                const float* xr = XP + (size_t)r * DM + col0; float* orow = OUT + (size_t)r * DM + col0;
#pragma unroll
                for (int bj = 0; bj < 2; ++bj) {
                    *(f32x4*)(orow + bj * HALF) = acc[ai][bj][m][0] + *(const f32x4*)(xr + bj * HALF);
                    *(f32x4*)(orow + bj * HALF + 4) = acc[ai][bj][m][1] + *(const f32x4*)(xr + bj * HALF + 4); } }
    }
};
struct Epi2f {
    const float* XP; float* OUT; const float* FW; float* SSQ; unsigned* CNT; PG8_LAS unsigned char* LDSR;
    __device__ __forceinline__ void operator()(const f32x4 (&acc_)[2][2][4][2], const Unit& u, int wr, int wc, int fr, int fq) const {
        f32x4 (&acc)[2][2][4][2] = const_cast<f32x4 (&)[2][2][4][2]>(acc_);
        const int row0 = u.pm * BM + wr * 64 + fr, col0 = u.pn * BM + wc * 32 + 8 * fq;
#pragma unroll
        for (int ai = 0; ai < 2; ++ai)
#pragma unroll
            for (int m = 0; m < 4; ++m) { const int r = row0 + ai * HALF + m * 16; const float* xr = XP + (size_t)r * DM + col0; float ss = 0.f;
#pragma unroll
                for (int bj = 0; bj < 2; ++bj) {
                    const f32x4 v0 = acc[ai][bj][m][0] + __builtin_nontemporal_load((const f32x4*)(xr + bj * HALF)), v1 = acc[ai][bj][m][1] + __builtin_nontemporal_load((const f32x4*)(xr + bj * HALF + 4));
                    acc[ai][bj][m][0] = v0; acc[ai][bj][m][1] = v1;
                    ss += (v0[0] * v0[0] + v0[1] * v0[1]) + (v0[2] * v0[2] + v0[3] * v0[3]) + (v1[0] * v1[0] + v1[1] * v1[1]) + (v1[2] * v1[2] + v1[3] * v1[3]); }
                ss += __shfl_xor(ss, 16); ss += __shfl_xor(ss, 32);
                if (fq == 0) __hip_atomic_store(SSQ + (size_t)r * 32 + u.pn * 4 + wc, ss, __ATOMIC_RELAXED, __HIP_MEMORY_SCOPE_AGENT); }
        asm volatile("s_waitcnt vmcnt(0)" ::: "memory");
        __syncthreads();
        if (threadIdx.x == 0) {
            unsigned* c = CNT + 64 * u.pm;
            (void)__hip_atomic_fetch_add(c, 1u, __ATOMIC_RELAXED, __HIP_MEMORY_SCOPE_AGENT);
            unsigned sp = 0;
            while (__hip_atomic_load(c, __ATOMIC_RELAXED, __HIP_MEMORY_SCOPE_AGENT) < 8u) { __builtin_amdgcn_s_sleep(1); if (++sp > (1u << 22)) break; }
        }
        __syncthreads();
        float rstd[2][4];
        {
            const int tid = threadIdx.x, prow = tid >> 1, half = tid & 1;
            const unsigned long long* sq = (const unsigned long long*)(SSQ + (size_t)(u.pm * BM + prow) * 32 + half * 16);
            float p = 0.f;
#pragma unroll
            for (int k = 0; k < 8; ++k) { const unsigned long long v = __hip_atomic_load(sq + k, __ATOMIC_RELAXED, __HIP_MEMORY_SCOPE_AGENT); p += __uint_as_float((unsigned)v) + __uint_as_float((unsigned)(v >> 32)); }
            p += __shfl_xor(p, 1);
            if (half == 0) ((PG8_LAS float*)LDSR)[prow] = rsqrtf(p * (1.f / DM) + EPS);
            __syncthreads();
#pragma unroll
            for (int ai = 0; ai < 2; ++ai)
#pragma unroll
                for (int m = 0; m < 4; ++m) rstd[ai][m] = ((PG8_LAS const float*)LDSR)[ai * HALF + wr * 64 + m * 16 + fr];
        }
        f32x4 fw[2][2];
#pragma unroll
        for (int bj = 0; bj < 2; ++bj)
#pragma unroll
            for (int n = 0; n < 2; ++n) fw[bj][n] = *(const f32x4*)(FW + col0 + bj * HALF + 4 * n);
#pragma unroll
        for (int ai = 0; ai < 2; ++ai)
#pragma unroll
            for (int m = 0; m < 4; ++m) { float* orow = OUT + (size_t)(row0 + ai * HALF + m * 16) * DM + col0;
#pragma unroll
                for (int bj = 0; bj < 2; ++bj) { *(f32x4*)(orow + bj * HALF) = acc[ai][bj][m][0] * rstd[ai][m] * fw[bj][0]; *(f32x4*)(orow + bj * HALF + 4) = acc[ai][bj][m][1] * rstd[ai][m] * fw[bj][1]; } }
    }
};
struct Epi2s {
    bf16_t* PART;
    __device__ __forceinline__ void operator()(const f32x4 (&acc)[2][2][4][2], const Unit& u, int wr, int wc, int fr, int fq) const {
        const int row0 = (u.pm - 32) * BM + wr * 64 + fr, col0 = u.pn * BM + wc * 32 + 8 * fq;
#pragma unroll
        for (int ai = 0; ai < 2; ++ai)
#pragma unroll
            for (int m = 0; m < 4; ++m) { bf16_t* orow = PART + (size_t)(row0 + ai * HALF + m * 16) * DM + col0;
#pragma unroll
                for (int bj = 0; bj < 2; ++bj) { const f32x4 v0 = acc[ai][bj][m][0], v1 = acc[ai][bj][m][1];
                    u32x4 w; w.x = cvt_pk_bf16(v0[0], v0[1]); w.y = cvt_pk_bf16(v0[2], v0[3]); w.z = cvt_pk_bf16(v1[0], v1[1]); w.w = cvt_pk_bf16(v1[2], v1[3]);
                    *(u32x4*)(orow + bj * HALF) = w; } }
    }
};
}

__device__ __forceinline__ int drow_in(int sc) {
    if (sc < 5120) return sc;
    const int s2 = sc - 5152, kind = s2 >> 11, ch = s2 & 2047;
    return 5120 + (ch >> 6) * 256 + 128 * (kind >> 1) + 4 * (kind & 1) + 32 * ((ch >> 4) & 3) + 8 * ((ch >> 2) & 3) + (ch & 3);
}
struct TItem { const float* src; bf16_t* dst; int K, N, n0; };
__device__ __forceinline__ TItem titem(int it, const float* win, const float* wout, bf16_t* WinT, bf16_t* WoutT) {
    constexpr int I_IN = 32 * 26;
    TItem t;
    if (it < I_IN) { const int kb = it / 26, nb = it % 26, nd = nb * 512, ns = nd < 5120 ? nd : nd + 32; t.src = win + (size_t)(kb * 64) * DIN + ns; t.dst = WinT + kb * 64; t.K = 2048; t.N = DIN; t.n0 = ns; }
    else { const int r = it - I_IN, kb = r / 4, nb = r % 4; t.src = wout + (size_t)(kb * 64) * 2048 + nb * 512; t.dst = WoutT + (size_t)(nb * 512) * 4096 + kb * 64; t.K = 4096; t.N = 2048; t.n0 = -1; }
    return t;
}
__device__ __forceinline__ void transpose_items(int first, int it0, int it1, int stride, const float* win, const float* wout, bf16_t* WinT, bf16_t* WoutT, float* scr, int tid) {
    const int r = tid >> 7, q = tid & 127, c = tid & 7, nr = tid >> 3;
    f32x4 v[16];
    int it = it0 + first;
    TItem cur = titem(it < it1 ? it : it0, win, wout, WinT, WoutT);
    if (it < it1) {
#pragma unroll
        for (int i = 0; i < 16; ++i) v[i] = __builtin_nontemporal_load((const f32x4*)(cur.src + (size_t)(4 * i + r) * cur.N + 4 * q));
    }
    for (; it < it1; it += stride) {
        __syncthreads();
#pragma unroll
        for (int i = 0; i < 16; ++i) { float* s = scr + (4 * i + r) * 513 + 4 * q; s[0] = v[i][0]; s[1] = v[i][1]; s[2] = v[i][2]; s[3] = v[i][3]; }
        const TItem me = cur;
        if (it + stride < it1) { cur = titem(it + stride, win, wout, WinT, WoutT);
#pragma unroll
            for (int i = 0; i < 16; ++i) v[i] = __builtin_nontemporal_load((const f32x4*)(cur.src + (size_t)(4 * i + r) * cur.N + 4 * q)); }
        __syncthreads();
#pragma unroll
        for (int j = 0; j < 8; ++j) { const int n = nr + 64 * j; const float* s = scr + (8 * c) * 513 + n;
            u32x4 o; o.x = cvt_pk_bf16(s[0 * 513], s[1 * 513]); o.y = cvt_pk_bf16(s[2 * 513], s[3 * 513]); o.z = cvt_pk_bf16(s[4 * 513], s[5 * 513]); o.w = cvt_pk_bf16(s[6 * 513], s[7 * 513]);
            const int dr = me.n0 >= 0 ? drow_in(me.n0 + n) : n;
            *(u32x4*)(me.dst + (size_t)dr * me.K + 8 * c) = o; }
    }
    __syncthreads();
}
constexpr int T_IN = 32 * 26, T_ALL = 32 * 26 + 64 * 4;
__device__ __forceinline__ void phase0(const float* xp, const float* xs, const float* normw, const float* win, const float* wout,
                                       bf16_t* WinT, bf16_t* WoutT, bf16_t* H, unsigned char* lds, int tid, int lane, int wave, int G) {
    float* scr = (float*)lds;
    const int gw = blockIdx.x * 8 + wave, NGW = G * 8;
    transpose_items((int)blockIdx.x, 0, T_IN, G, win, wout, WinT, WoutT, scr, tid);
    const int gt = blockIdx.x * 512 + tid, NGT = G * 512;
    for (int idx = gt; idx < 65536; idx += NGT) { const int n = idx & 31, k = idx >> 5; WinT[(size_t)(13312 + n) * 2048 + k] = (bf16_t)(cvt_pk_bf16(win[(size_t)k * DIN + 5120 + n], 0.f) & 0xffffu); }
    for (int idx = gt; idx < 57344; idx += NGT) ((u32x4*)(WinT + (size_t)13344 * 2048))[idx] = (u32x4){0u, 0u, 0u, 0u};
    {
        f32x4 nv[8];
        if (gw < MT) { const f32x4* xr = (const f32x4*)(gw < MP ? xp + (size_t)gw * DM : xs + (size_t)(gw - MP) * DM) + lane;
#pragma unroll
            for (int j = 0; j < 8; ++j) nv[j] = __builtin_nontemporal_load(xr + 64 * j); }
        for (int m = gw; m < MT; m += NGW) {
            f32x4 v[8]; float ss = 0.f;
#pragma unroll
            for (int j = 0; j < 8; ++j) { v[j] = nv[j]; ss += (v[j][0] * v[j][0] + v[j][1] * v[j][1]) + (v[j][2] * v[j][2] + v[j][3] * v[j][3]); }
            const int mn = m + NGW;
            if (mn < MT) { const f32x4* xr = (const f32x4*)(mn < MP ? xp + (size_t)mn * DM : xs + (size_t)(mn - MP) * DM) + lane;
#pragma unroll
                for (int j = 0; j < 8; ++j) nv[j] = __builtin_nontemporal_load(xr + 64 * j); }
            const float rs = rsqrtf(wave_sum(ss) * (1.f / DM) + EPS);
            u32x2* o = (u32x2*)(H + (size_t)m * DM) + lane;
#pragma unroll
            for (int j = 0; j < 8; ++j) { const f32x4 w = ((const f32x4*)normw)[64 * j + lane]; u32x2 p; p.x = cvt_pk_bf16(v[j][0] * rs * w[0], v[j][1] * rs * w[1]); p.y = cvt_pk_bf16(v[j][2] * rs * w[2], v[j][3] * rs * w[3]); o[64 * j] = p; }
        }
    }
}

constexpr int PITCH = 136;
constexpr int L_BM = 34816, L_XT = 69632, L_HP = 87040, L_DT = 104448, L_AC = 108544, L_SC = 112640;
constexpr int C_CM = 0, C_MW = 34816, C_X0 = 69632, C_H0 = 87040, C_X1 = 104448, C_H1 = 121856, C_DT = 139264, C_AC = 143360;

template <int ODT, int OAC, int OSC>
__device__ __forceinline__ void ssd_setup(const float* DT, const float* alog, int R0, int g, unsigned char* lds, int lane, int w) {
    const int hg = g * 8 + w; const float a = -expf(alog[hg]);
    const float dt0 = DT[(size_t)(R0 + 2 * lane) * 32 + hg], dt1 = DT[(size_t)(R0 + 2 * lane + 1) * 32 + hg];
    const float la0 = dt0 * a, la1 = dt1 * a; float s = la0 + la1;
#pragma unroll
    for (int o = 1; o < 64; o <<= 1) { const float t = __shfl_up(s, o); if (lane >= o) s += t; }
    const float ac1 = s, ac0 = s - la1, tot = __shfl(s, 63);
    ((f32x2*)(lds + ODT))[w * 64 + lane] = (f32x2){dt0, dt1};
    ((f32x2*)(lds + OAC))[w * 64 + lane] = (f32x2){ac0, ac1};
    if (OSC >= 0) ((f32x2*)(lds + (OSC >= 0 ? OSC : 0)))[w * 64 + lane] = (f32x2){dt0 * __expf(tot - ac0), dt1 * __expf(tot - ac1)};
}

struct ConvRaw { unsigned v[11]; f32x2 w[4]; f32x2 b; };
__device__ __forceinline__ void conv_load(ConvRaw& r, const bf16_t* src, bool first, int ls, const float* cw, const float* cb) {
#pragma unroll
    for (int i = 0; i < 11; ++i) { const int l = ls - 3 + i; unsigned v = 0u; if (!(first && l < 0)) v = *(const unsigned*)(src + (long)l * LDP); r.v[i] = v; }
#pragma unroll
    for (int i = 0; i < 4; ++i) r.w[i] = *(const f32x2*)(cw + i * 3072);
    r.b = *(const f32x2*)cb;
}
__device__ __forceinline__ void conv_compute(const ConvRaw& r, float (&o0)[8], float (&o1)[8]) {
    float lo[11], hi[11];
#pragma unroll
    for (int i = 0; i < 11; ++i) { lo[i] = bf_lo(r.v[i]); hi[i] = bf_hi(r.v[i]); }
#pragma unroll
    for (int j = 0; j < 8; ++j) {
        o0[j] = silu_f(r.b[0] + r.w[0][0] * lo[j] + r.w[1][0] * lo[j + 1] + r.w[2][0] * lo[j + 2] + r.w[3][0] * lo[j + 3]);
        o1[j] = silu_f(r.b[1] + r.w[0][1] * hi[j] + r.w[1][1] * hi[j + 1] + r.w[2][1] * hi[j + 2] + r.w[3][1] * hi[j + 3]);
    }
}
__device__ __forceinline__ u32x4 pack8(const float (&o)[8]) { u32x4 p; p.x = cvt_pk_bf16(o[0], o[1]); p.y = cvt_pk_bf16(o[2], o[3]); p.z = cvt_pk_bf16(o[4], o[5]); p.w = cvt_pk_bf16(o[6], o[7]); return p; }
template <bool TR>
__device__ __forceinline__ void conv_task(const bf16_t* src, bool first, int ls, const float* cw, const float* cb, bf16_t* img, int chl) {
    ConvRaw r; conv_load(r, src, first, ls, cw, cb);
    float o0[8], o1[8]; conv_compute(r, o0, o1);
    if (TR) { *(u32x4*)(img + chl * PITCH + ls) = pack8(o0); *(u32x4*)(img + (chl + 1) * PITCH + ls) = pack8(o1); }
    else {
#pragma unroll
        for (int j = 0; j < 8; ++j) *(unsigned*)(img + (ls + j) * PITCH + chl) = cvt_pk_bf16(o0[j], o1[j]);
    }
}

__device__ __forceinline__ void ssd_passA(int u, const bf16_t* PROJ, const float* DT, const float* alog, const float* cw, const float* cbias,
                                          float* S, float* CDEC, bf16_t* XTg, unsigned char* lds, int tid, int lane, int w) {
    const int b = u >> 6, c = (u >> 2) & 15, g = u & 3, R0 = b * 2048 + c * 128; const bool first = (c == 0);
    const int fr = lane & 15, fq = lane >> 4;
    bf16_t* BT = (bf16_t*)(lds + L_BM);
    const bf16_t* src0 = PROJ + (size_t)R0 * LDP + XB;
    ssd_setup<L_DT, L_AC, L_SC>(DT, alog, R0, g, lds, lane, w);
#pragma unroll
    for (int i = 0; i < 2; ++i) { const int task = tid + 512 * i, pr = task & 63, lg = task >> 6, ch = 2048 + g * 128 + 2 * pr;
        conv_task<true>(src0 + ch, first, lg * 8, cw + ch, cbias + ch, BT, 2 * pr); }
    const int pr = tid & 31, lg = tid >> 5;
    ConvRaw raw; { const int ch = g * 512 + 2 * pr; conv_load(raw, src0 + ch, first, lg * 8, cw + ch, cbias + ch); }
    __syncthreads();
    const int pw = w & 3, nb = (w >> 2) * 64;
    bf16x8 btf[4][4];
#pragma unroll
    for (int nt = 0; nt < 4; ++nt)
#pragma unroll
        for (int ks = 0; ks < 4; ++ks) btf[nt][ks] = *(const bf16x8*)(BT + (nb + 16 * nt + fr) * PITCH + 32 * ks + 8 * fq);
    for (int h8 = 0; h8 < 8; ++h8) {
        const int hg = g * 8 + h8; const size_t tile = (size_t)((b * 16 + c) * 32 + hg) * 8192;
        float o0[8], o1[8]; conv_compute(raw, o0, o1);
        if (h8 < 7) { const int ch = g * 512 + (h8 + 1) * 64 + 2 * pr; conv_load(raw, src0 + ch, first, lg * 8, cw + ch, cbias + ch); }
        { bf16_t* xg = XTg + tile + (2 * pr) * 128 + lg * 8; *(u32x4*)xg = pack8(o0); *(u32x4*)(xg + 128) = pack8(o1); }
        { const float* sc = (const float*)(lds + L_SC) + h8 * 128 + lg * 8; const f32x4 s0 = *(const f32x4*)sc, s1 = *(const f32x4*)(sc + 4);
#pragma unroll
          for (int j = 0; j < 4; ++j) { o0[j] *= s0[j]; o1[j] *= s0[j]; o0[4 + j] *= s1[j]; o1[4 + j] *= s1[j]; } }
        bf16_t* XT = (bf16_t*)(lds + ((h8 & 1) ? L_HP : L_XT));
        *(u32x4*)(XT + (2 * pr) * PITCH + lg * 8) = pack8(o0); *(u32x4*)(XT + (2 * pr + 1) * PITCH + lg * 8) = pack8(o1);
        __syncthreads();
        f32x4 acc[4];
#pragma unroll
        for (int nt = 0; nt < 4; ++nt) acc[nt] = (f32x4){0.f, 0.f, 0.f, 0.f};
#pragma unroll
        for (int ks = 0; ks < 4; ++ks) { const bf16x8 xf = *(const bf16x8*)(XT + (16 * pw + fr) * PITCH + 32 * ks + 8 * fq);
#pragma unroll
            for (int nt = 0; nt < 4; ++nt) acc[nt] = __builtin_amdgcn_mfma_f32_16x16x32_bf16(btf[nt][ks], xf, acc[nt], 0, 0, 0); }
        float* sp = S + tile + (16 * pw + fr) * 128 + nb + 4 * fq;
#pragma unroll
        for (int nt = 0; nt < 4; ++nt) *(f32x4*)(sp + 16 * nt) = acc[nt];
        if (tid == 0) CDEC[(b * 16 + c) * 32 + hg] = __expf(((const float*)(lds + L_AC))[h8 * 128 + 127]);
    }
    __syncthreads();
}

__device__ __forceinline__ void ssd_passC(int u, const bf16_t* PROJ, const float* DT, const float* alog, const float* cw, const float* cbias, const float* dskip,
                                          const float* snw, const bf16_t* XTg, const bf16_t* HPB, bf16_t* YCAT, unsigned char* lds, int tid, int lane, int w) {
    const int b = u >> 6, c = (u >> 2) & 15, g = u & 3, R0 = b * 2048 + c * 128; const bool first = (c == 0);
    const int fr = lane & 15, fq = lane >> 4, l0 = 16 * w;
    bf16_t* Cm = (bf16_t*)(lds + C_CM); bf16_t* Bm = (bf16_t*)(lds + C_X0);
    bf16_t* Mw = (bf16_t*)(lds + C_MW + w * 4352);
    const float* DTs = (const float*)(lds + C_DT); const float* ACs = (const float*)(lds + C_AC);
    const bf16_t* src0 = PROJ + (size_t)R0 * LDP + XB;
    const size_t row = (size_t)(R0 + l0 + fr);
    const size_t tile0 = (size_t)((b * 16 + c) * 32 + g * 8) * 8192;
    ssd_setup<C_DT, C_AC, -1>(DT, alog, R0, g, lds, lane, w);
#pragma unroll
    for (int i = 0; i < 2; ++i) { const int task = tid + 512 * i, pr = task & 63, lg = task >> 6;
        const int chB = 2048 + g * 128 + 2 * pr, chC = 2560 + g * 128 + 2 * pr;
        conv_task<false>(src0 + chB, first, lg * 8, cw + chB, cbias + chB, Bm, 2 * pr);
        conv_task<false>(src0 + chC, first, lg * 8, cw + chC, cbias + chC, Cm, 2 * pr); }
    u32x4 xr[2], hr[2]; u32x2 zn[4];
#define PC_LOADS(h8n) do { const size_t _t = tile0 + (size_t)(h8n) * 8192; \
        _Pragma("unroll") for (int _i = 0; _i < 2; ++_i) { xr[_i] = __builtin_nontemporal_load((const u32x4*)(XTg + _t) + tid + 512 * _i); hr[_i] = __builtin_nontemporal_load((const u32x4*)(HPB + _t) + tid + 512 * _i); } \
        _Pragma("unroll") for (int _p = 0; _p < 4; ++_p) zn[_p] = *(const u32x2*)(PROJ + row * LDP + (g * 8 + (h8n)) * 64 + 16 * _p + 4 * fq); } while (0)
    PC_LOADS(0);
    __syncthreads();
    bf16x8 cfrag[4];
#pragma unroll
    for (int ks = 0; ks < 4; ++ks) cfrag[ks] = *(const bf16x8*)(Cm + (l0 + fr) * PITCH + 32 * ks + 8 * fq);
    f32x4 cbv[8];
#pragma unroll
    for (int ts = 0; ts < 8; ++ts) { cbv[ts] = (f32x4){0.f, 0.f, 0.f, 0.f};
        if (ts <= w) {
#pragma unroll
            for (int ks = 0; ks < 4; ++ks) { const bf16x8 bfr = *(const bf16x8*)(Bm + (16 * ts + fr) * PITCH + 32 * ks + 8 * fq);
                cbv[ts] = __builtin_amdgcn_mfma_f32_16x16x32_bf16(bfr, cfrag[ks], cbv[ts], 0, 0, 0); } } }
    __syncthreads();
    float ssq = 0.f;
    for (int h8 = 0; h8 < 8; ++h8) {
        const int hg = g * 8 + h8;
        bf16_t* XT = (bf16_t*)(lds + ((h8 & 1) ? C_X1 : C_X0)); bf16_t* HP = (bf16_t*)(lds + ((h8 & 1) ? C_H1 : C_H0));
#pragma unroll
        for (int i = 0; i < 2; ++i) { const int piece = tid + 512 * i, p = piece >> 4, l8 = piece & 15;
            *(u32x4*)(XT + p * PITCH + 8 * l8) = xr[i]; *(u32x4*)(HP + p * PITCH + 8 * l8) = hr[i]; }
        u32x2 zc[4];
#pragma unroll
        for (int pt = 0; pt < 4; ++pt) zc[pt] = zn[pt];
        const float ac_l = ACs[h8 * 128 + l0 + fr];
#pragma unroll
        for (int ts = 0; ts < 8; ++ts) {
            if (ts <= (w | 1)) {
                u32x2 o = (u32x2){0u, 0u};
                if (ts <= w) {
                    const f32x4 acs = *(const f32x4*)(ACs + h8 * 128 + 16 * ts + 4 * fq), dts = *(const f32x4*)(DTs + h8 * 128 + 16 * ts + 4 * fq);
                    float mv[4];
#pragma unroll
                    for (int r = 0; r < 4; ++r) { const bool valid = (ts < w) || (4 * fq + r <= fr); const float e = __expf(fminf(ac_l - acs[r], 0.f)); mv[r] = valid ? cbv[ts][r] * e * dts[r] : 0.f; }
                    o.x = cvt_pk_bf16(mv[0], mv[1]); o.y = cvt_pk_bf16(mv[2], mv[3]);
                }
                *(u32x2*)(Mw + fr * PITCH + 16 * ts + 4 * fq) = o;
            }
        }
        __syncthreads();
        if (h8 < 7) PC_LOADS(h8 + 1);
        f32x4 acc[4];
#pragma unroll
        for (int pt = 0; pt < 4; ++pt) acc[pt] = (f32x4){0.f, 0.f, 0.f, 0.f};
#pragma unroll
        for (int ks = 0; ks < 4; ++ks)
#pragma unroll
            for (int pt = 0; pt < 4; ++pt) { const bf16x8 hf = *(const bf16x8*)(HP + (16 * pt + fr) * PITCH + 32 * ks + 8 * fq);
                acc[pt] = __builtin_amdgcn_mfma_f32_16x16x32_bf16(hf, cfrag[ks], acc[pt], 0, 0, 0); }
        const float el = __expf(ac_l);
#pragma unroll
        for (int pt = 0; pt < 4; ++pt) acc[pt] = acc[pt] * el;
#pragma unroll
        for (int ks = 0; ks < 4; ++ks) {
            if (ks <= (w >> 1)) { const bf16x8 mf = *(const bf16x8*)(Mw + fr * PITCH + 32 * ks + 8 * fq);
#pragma unroll
                for (int pt = 0; pt < 4; ++pt) { const bf16x8 xf = *(const bf16x8*)(XT + (16 * pt + fr) * PITCH + 32 * ks + 8 * fq);
                    acc[pt] = __builtin_amdgcn_mfma_f32_16x16x32_bf16(xf, mf, acc[pt], 0, 0, 0); } } }
        const float Dh = dskip[hg];
#pragma unroll
        for (int pt = 0; pt < 4; ++pt) { const int p0 = 16 * pt + 4 * fq;
            const float z[4] = {bf_lo(zc[pt].x), bf_hi(zc[pt].x), bf_lo(zc[pt].y), bf_hi(zc[pt].y)};
            float yg[4];
#pragma unroll
            for (int r = 0; r < 4; ++r) { const float x = bf2f(XT[(p0 + r) * PITCH + l0 + fr]); yg[r] = (acc[pt][r] + Dh * x) * z[r]; ssq += yg[r] * yg[r]; }
            u32x2 o; o.x = cvt_pk_bf16(yg[0], yg[1]); o.y = cvt_pk_bf16(yg[2], yg[3]);
            *(u32x2*)(YCAT + row * DMIX + hg * 64 + p0) = o; }
    }
#undef PC_LOADS
    ssq += __shfl_xor(ssq, 16); ssq += __shfl_xor(ssq, 32);
    const float rstd = rsqrtf(ssq * (1.f / 512.f) + EPS);
    {
        const f32x4 nw0 = *(const f32x4*)(snw + g * 512 + 8 * lane), nw1 = *(const f32x4*)(snw + g * 512 + 8 * lane + 4);
#pragma unroll 4
        for (int r = 0; r < 16; ++r) {
            const float rs = __shfl(rstd, r);
            u32x4* yp = (u32x4*)(YCAT + (size_t)(R0 + l0 + r) * DMIX + g * 512 + 8 * lane);
            const u32x4 v = *yp; u32x4 o;
            o.x = cvt_pk_bf16(bf_lo(v.x) * rs * nw0[0], bf_hi(v.x) * rs * nw0[1]); o.y = cvt_pk_bf16(bf_lo(v.y) * rs * nw0[2], bf_hi(v.y) * rs * nw0[3]);
            o.z = cvt_pk_bf16(bf_lo(v.z) * rs * nw1[0], bf_hi(v.z) * rs * nw1[1]); o.w = cvt_pk_bf16(bf_lo(v.w) * rs * nw1[2], bf_hi(v.w) * rs * nw1[3]);
            *yp = o;
        }
    }
    __syncthreads();
}

__device__ __forceinline__ void state_scan(const float* S, const float* CDEC, bf16_t* HPB, float* out, int tid, int G) {
    for (int idx = blockIdx.x * 512 + tid; idx < 4 * 32 * 2048; idx += G * 512) {
        const int bh = idx >> 11, e4 = idx & 2047, b = bh >> 5, hg = bh & 31;
        f32x4 s[16]; float d[16];
#pragma unroll
        for (int c = 0; c < 16; ++c) { s[c] = __builtin_nontemporal_load((const f32x4*)(S + ((size_t)((b * 16 + c) * 32 + hg)) * 8192 + 4 * e4)); d[c] = CDEC[(b * 16 + c) * 32 + hg]; }
        f32x4 h = (f32x4){0.f, 0.f, 0.f, 0.f};
#pragma unroll
        for (int c = 0; c < 16; ++c) { u32x2 o; o.x = cvt_pk_bf16(h[0], h[1]); o.y = cvt_pk_bf16(h[2], h[3]);
            *(u32x2*)(HPB + ((size_t)((b * 16 + c) * 32 + hg)) * 8192 + 4 * e4) = o; h = h * d[c] + s[c]; }
        *(f32x4*)(out + O_SSMP + (size_t)bh * 8192 + 4 * e4) = h;
    }
}

constexpr int SB_BS = 0, SB_CS = 4096, SB_RED = 8192, SB_WB = 8448, SB_WSZ = 9216;
__device__ __forceinline__ void sample_unit(int u, const bf16_t* PROJ, const float* DT, const float* alog, const float* cw, const float* cbias, const float* dskip, const float* snw,
                                            const float* state, const float* cstate, float* out, bf16_t* YCAT, unsigned char* lds, int tid, int lane, int w) {
    const int b = u >> 2, g = u & 3, hg = g * 8 + w;
    const size_t prow = (size_t)(MP + b * 8);
    float* BS = (float*)(lds + SB_BS); float* CS = (float*)(lds + SB_CS); float* RED = (float*)(lds + SB_RED); float* Wb = (float*)(lds + SB_WB + w * SB_WSZ);
    const float* st = state + (size_t)(b * 32 + hg) * 8192; float* so = out + O_SSMS + (size_t)(b * 32 + hg) * 8192;
    const int lr8 = lane >> 3, lc8 = (lane & 7) * 4;
    f32x4 sa[8];
#pragma unroll
    for (int i = 0; i < 8; ++i) sa[i] = __builtin_nontemporal_load((const f32x4*)(st + (lr8 + 8 * i) * 128 + lc8));
    if (tid < 256) {
        const int ch = tid < 128 ? 2048 + g * 128 + tid : 2560 + g * 128 + (tid - 128);
        float v[11];
#pragma unroll
        for (int i = 0; i < 3; ++i) v[i] = cstate[(size_t)(b * 3 + i) * 3072 + ch];
#pragma unroll
        for (int t = 0; t < 8; ++t) v[3 + t] = bf2f(PROJ[(prow + t) * LDP + XB + ch]);
        const float w0 = cw[ch], w1 = cw[3072 + ch], w2 = cw[6144 + ch], w3 = cw[9216 + ch], bb = cbias[ch];
        float* dst = tid < 128 ? BS + tid : CS + (tid - 128);
#pragma unroll
        for (int t = 0; t < 8; ++t) dst[t * 128] = silu_f(bb + w0 * v[t] + w1 * v[t + 1] + w2 * v[t + 2] + w3 * v[t + 3]);
#pragma unroll
        for (int i = 0; i < 3; ++i) out[O_CSS + (size_t)(b * 3 + i) * 3072 + ch] = v[8 + i];
    }
    float xv[8], xp[8], dA[8];
    {
        const int ch = hg * 64 + lane;
        float v[11];
#pragma unroll
        for (int i = 0; i < 3; ++i) v[i] = cstate[(size_t)(b * 3 + i) * 3072 + ch];
#pragma unroll
        for (int t = 0; t < 8; ++t) v[3 + t] = bf2f(PROJ[(prow + t) * LDP + XB + ch]);
        const float w0 = cw[ch], w1 = cw[3072 + ch], w2 = cw[6144 + ch], w3 = cw[9216 + ch], bb = cbias[ch];
        const float a = -expf(alog[hg]);
#pragma unroll
        for (int t = 0; t < 8; ++t) { xv[t] = silu_f(bb + w0 * v[t] + w1 * v[t + 1] + w2 * v[t + 2] + w3 * v[t + 3]);
            const float dt = DT[(prow + t) * 32 + hg]; xp[t] = xv[t] * dt; dA[t] = __expf(dt * a); }
#pragma unroll
        for (int i = 0; i < 3; ++i) out[O_CSS + (size_t)(b * 3 + i) * 3072 + ch] = v[8 + i];
    }
    bf16_t zv[8];
#pragma unroll
    for (int t = 0; t < 8; ++t) zv[t] = PROJ[(prow + t) * LDP + g * 512 + w * 64 + lane];
    __syncthreads();
    f32x2 yv[8];
#pragma unroll
    for (int t = 0; t < 8; ++t) yv[t] = (f32x2){0.f, 0.f};
#pragma unroll 1
    for (int sc = 0; sc < 4; ++sc) {
#pragma unroll
        for (int i = 0; i < 8; ++i) *(f32x4*)(Wb + (lr8 + 8 * i) * 36 + lc8) = sa[i];
        if (sc < 3) {
#pragma unroll
            for (int i = 0; i < 8; ++i) sa[i] = __builtin_nontemporal_load((const f32x4*)(st + (lr8 + 8 * i) * 128 + (sc + 1) * 32 + lc8));
        }
#pragma unroll
        for (int hf = 0; hf < 2; ++hf) {
            const int ck = 2 * sc + hf;
            f32x4 hq[4];
#pragma unroll
            for (int q = 0; q < 4; ++q) hq[q] = *(const f32x4*)(Wb + lane * 36 + hf * 16 + 4 * q);
#pragma unroll
            for (int t = 0; t < 8; ++t) {
#pragma unroll
                for (int q = 0; q < 4; ++q) { const f32x4 Bq = *(const f32x4*)(BS + t * 128 + ck * 16 + 4 * q), Cq = *(const f32x4*)(CS + t * 128 + ck * 16 + 4 * q);
                    hq[q] = hq[q] * dA[t] + Bq * xp[t];
                    yv[t] = yv[t] + (f32x2){hq[q][0], hq[q][1]} * (f32x2){Cq[0], Cq[1]} + (f32x2){hq[q][2], hq[q][3]} * (f32x2){Cq[2], Cq[3]}; }
                __builtin_amdgcn_sched_barrier(0);
            }
#pragma unroll
            for (int q = 0; q < 4; ++q) *(f32x4*)(Wb + lane * 36 + hf * 16 + 4 * q) = hq[q];
        }
#pragma unroll
        for (int i = 0; i < 8; ++i) { const f32x4 v = *(const f32x4*)(Wb + (lr8 + 8 * i) * 36 + lc8); __builtin_nontemporal_store(v, (f32x4*)(so + (lr8 + 8 * i) * 128 + sc * 32 + lc8)); }
    }
    {
        const int ch = g * 512 + w * 64 + lane; const float Dh = dskip[hg], nw = snw[ch];
        float yg[8];
#pragma unroll
        for (int t = 0; t < 8; ++t) { const float z = bf2f(zv[t]); const float y = (yv[t][0] + yv[t][1]) + Dh * xv[t]; yg[t] = y * z;
            const float sq = wave_sum(yg[t] * yg[t]); if (lane == 0) RED[t * 8 + w] = sq; }
        __syncthreads();
#pragma unroll
        for (int t = 0; t < 8; ++t) { float tot = 0.f;
#pragma unroll
            for (int k = 0; k < 8; ++k) tot += RED[t * 8 + k];
            const float rstd = rsqrtf(tot * (1.f / 512.f) + EPS);
            YCAT[(prow + t) * DMIX + ch] = (bf16_t)(cvt_pk_bf16(yg[t] * rstd * nw, 0.f) & 0xffffu); }
    }
    __syncthreads();
}

__device__ __forceinline__ void unpack8(const u32x4 p, float (&f)[8]) {
#pragma unroll
    for (int q = 0; q < 4; ++q) { f[2 * q] = bf_lo(p[q]); f[2 * q + 1] = bf_hi(p[q]); }
}
__device__ __forceinline__ void short_conv(const bf16_t* PROJ, const float* csw, const float* cshort, float* out, bf16_t* YCAT, int tid, int G) {
    for (int task = blockIdx.x * 512 + tid; task < 1152 * 256; task += G * 512) {
        const int rb = task >> 8, cgp = task & 255, c0 = 8 * cgp; const size_t r0 = (size_t)rb * 8;
        u32x4 ur[8], gr[8];
#pragma unroll
        for (int t = 0; t < 8; ++t) { ur[t] = __builtin_nontemporal_load((const u32x4*)(PROJ + (r0 + t) * LDP + UC + c0)); gr[t] = __builtin_nontemporal_load((const u32x4*)(PROJ + (r0 + t) * LDP + GC + c0)); }
        float w[3][8];
#pragma unroll
        for (int i = 0; i < 3; ++i) { const f32x4 a = *(const f32x4*)(csw + i * 2048 + c0), bq = *(const f32x4*)(csw + i * 2048 + c0 + 4);
            w[i][0] = a[0]; w[i][1] = a[1]; w[i][2] = a[2]; w[i][3] = a[3]; w[i][4] = bq[0]; w[i][5] = bq[1]; w[i][6] = bq[2]; w[i][7] = bq[3]; }
        float u2[8], u1[8];
        if (rb >= 1024) { const int b = rb - 1024;
#pragma unroll
            for (int e = 0; e < 8; ++e) { u2[e] = cshort[(size_t)(b * 2 + 0) * 2048 + c0 + e]; u1[e] = cshort[(size_t)(b * 2 + 1) * 2048 + c0 + e]; }
        } else if ((rb & 255) == 0) {
#pragma unroll
            for (int e = 0; e < 8; ++e) { u2[e] = 0.f; u1[e] = 0.f; }
        } else {
            unpack8(*(const u32x4*)(PROJ + (r0 - 2) * LDP + UC + c0), u2); unpack8(*(const u32x4*)(PROJ + (r0 - 1) * LDP + UC + c0), u1);
        }
#pragma unroll
        for (int t = 0; t < 8; ++t) {
            float uu[8], gz[8], y[8];
            unpack8(ur[t], uu); unpack8(gr[t], gz);
#pragma unroll
            for (int e = 0; e < 8; ++e) y[e] = gz[e] * (w[0][e] * u2[e] + w[1][e] * u1[e] + w[2][e] * uu[e]);
            u32x4 o; o.x = cvt_pk_bf16(y[0], y[1]); o.y = cvt_pk_bf16(y[2], y[3]); o.z = cvt_pk_bf16(y[4], y[5]); o.w = cvt_pk_bf16(y[6], y[7]);
            *(u32x4*)(YCAT + (r0 + t) * DMIX + 2048 + c0) = o;
            if (t >= 6) {
                float* dst = nullptr;
                if (rb >= 1024) dst = out + O_CSHS + (size_t)((rb - 1024) * 2 + (t - 6)) * 2048 + c0;
                else if ((rb & 255) == 255) dst = out + O_CSHP + (size_t)((rb >> 8) * 2 + (t - 6)) * 2048 + c0;
                if (dst) { *(f32x4*)dst = (f32x4){uu[0], uu[1], uu[2], uu[3]}; *(f32x4*)(dst + 4) = (f32x4){uu[4], uu[5], uu[6], uu[7]}; }
            }
#pragma unroll
            for (int e = 0; e < 8; ++e) { u2[e] = u1[e]; u1[e] = uu[e]; }
        }
    }
}

#define XB_TMO      128
#define XB_XCNT(j)  (256  + 64 * (j))
#define XB_XSUB(j)  (1280 + 64 * (j))
#define XB_XGEN(j)  (2304 + 64 * (j))
#define XB_TOP      3328
#define XB_TOPGEN   3392
#define XCD_BAR_WORDS 3456
#define XB_SPIN_CAP (1u << 22)
__device__ __forceinline__ unsigned xb_ld(unsigned* p)              { return __hip_atomic_load(p, __ATOMIC_RELAXED, __HIP_MEMORY_SCOPE_AGENT); }
__device__ __forceinline__ unsigned xb_add(unsigned* p, unsigned v) { return __hip_atomic_fetch_add(p, v, __ATOMIC_RELAXED, __HIP_MEMORY_SCOPE_AGENT); }
__device__ __forceinline__ unsigned xb_xcc_id() { return (unsigned)__builtin_amdgcn_s_getreg((3 << 11) | 20) & 0xFu; }
#define XB_SPIN(cond, bar) do { unsigned _sp = 0; while (cond) { __builtin_amdgcn_s_sleep(1); \
    if ((++_sp & 255u) == 0u) { if (xb_ld(&(bar)[XB_TMO])) break; if (_sp > XB_SPIN_CAP) { atomicAdd(&(bar)[XB_TMO], 1u); break; } } } } while (0)
struct XcdBarrier { unsigned* bar; unsigned x; volatile LAS unsigned* st; };
__device__ __forceinline__ XcdBarrier xcd_barrier_post(unsigned* bar, volatile LAS unsigned* st) {
    XcdBarrier b; b.bar = bar; b.x = xb_xcc_id(); b.st = st;
    if (threadIdx.x == 0) (void)xb_add(&bar[XB_XCNT(b.x)], 1u);
    return b;
}
__device__ __forceinline__ void xcd_barrier_complete(unsigned* bar, unsigned x, unsigned& nloc, unsigned& nx) {
    const unsigned G = gridDim.x * gridDim.y * gridDim.z;
    unsigned sum, cnt, mine, sp = 0u;
    for (;;) {
        sum = 0u; cnt = 0u; mine = 0u;
#pragma unroll
        for (unsigned j = 0; j < 16; ++j) { const unsigned c = xb_ld(&bar[XB_XCNT(j)]); sum += c; cnt += (c > 0u) ? 1u : 0u; mine = (j == x) ? c : mine; }
        if (sum == G) break;
        __builtin_amdgcn_s_sleep(1);
        if ((++sp & 255u) == 0u) { if (xb_ld(&bar[XB_TMO])) break; if (sp > XB_SPIN_CAP) { atomicAdd(&bar[XB_TMO], 1u); break; } }
    }
    nloc = mine > 0u ? mine : 1u; nx = cnt > 0u ? cnt : 1u;
}
__device__ __forceinline__ void xcd_barrier(const XcdBarrier& b) {
    asm volatile("s_waitcnt vmcnt(0)" ::: "memory");
    __syncthreads();
    if (threadIdx.x == 0) {
        unsigned* bar = b.bar;
        __builtin_amdgcn_s_waitcnt(0);
        unsigned nloc = b.st[0], nx = b.st[1];
        if (nloc == 0u) { xcd_barrier_complete(bar, b.x, nloc, nx); b.st[0] = nloc; b.st[1] = nx; }
        const unsigned old = xb_add(&bar[XB_XSUB(b.x)], 1u);
        const unsigned gen = old / nloc;
        if (old + 1u == (gen + 1u) * nloc) {
            __builtin_amdgcn_fence(__ATOMIC_RELEASE, "agent");
            asm volatile("s_waitcnt vmcnt(0)" ::: "memory");
            const unsigned og = xb_add(&bar[XB_TOP], 1u);
            const unsigned tg = og / nx;
            if (og + 1u == (tg + 1u) * nx) xb_add(&bar[XB_TOPGEN], 1u);
            else XB_SPIN(xb_ld(&bar[XB_TOPGEN]) == tg, bar);
            __builtin_amdgcn_fence(__ATOMIC_ACQUIRE, "agent");
            xb_add(&bar[XB_XGEN(b.x)], 1u);
            asm volatile("s_waitcnt vmcnt(0)" ::: "memory");
        } else {
            XB_SPIN(xb_ld(&bar[XB_XGEN(b.x)]) == gen, bar);
            __builtin_amdgcn_fence(__ATOMIC_ACQUIRE, "agent");
            asm volatile("s_waitcnt vmcnt(0)" ::: "memory");
        }
    }
    __syncthreads();
}

struct Args { const float* in[16]; float* out; unsigned char* ws; };

__global__ void __launch_bounds__(512, 2) hymba_fwd(Args a) {
    extern __shared__ __attribute__((aligned(16))) unsigned char lds[];
    cg::grid_group grid = cg::this_grid();
    const int tid = threadIdx.x, lane = tid & 63, wave = __builtin_amdgcn_readfirstlane(tid >> 6), G = gridDim.x;
    typedef const __attribute__((address_space(4))) volatile unsigned long long* kargp_t;
#define KARG(i) ((const float*)(((kargp_t)__builtin_amdgcn_kernarg_segment_ptr())[(i)]))
#define KOUT ((float*)(((kargp_t)__builtin_amdgcn_kernarg_segment_ptr())[16]))
#define KWS ((unsigned char*)(((kargp_t)__builtin_amdgcn_kernarg_segment_ptr())[17]))
#define WSP(T, off) ((T*)(KWS + (off)))
    if (tid < 64) ((LAS unsigned*)((LAS unsigned char*)lds + LDS_ST))[tid] = 0u;
    __syncthreads();
    const XcdBarrier xbar = xcd_barrier_post((unsigned*)(KWS + WS_CTL), (volatile LAS unsigned*)((LAS unsigned char*)lds + LDS_ST));
    phase0(KARG(0), KARG(1), KARG(5), KARG(6), KARG(14), WSP(bf16_t, WS_WIN), WSP(bf16_t, WS_WOUT), WSP(bf16_t, WS_H), lds, tid, lane, wave, G);
    xcd_barrier(xbar);
    { pg8::Gemm g{WSP(bf16_t, WS_H), WSP(bf16_t, WS_WIN), MT, N1, DM, DM}; pg8::StaticOrder So; So.init(MT, N1, G, (int)blockIdx.x); pg8::Epi1 E{WSP(bf16_t, WS_PROJ), WSP(float, WS_DT), KARG(9)};
      pg8::gemm_phase<pg8::Epi1, pg8::StaticOrder>((LAS unsigned char*)lds, g, So, E); }
    {
      const int nfull = (MT / 256) * (N1 / 256) % G, nidle = G - nfull;
      if (nfull == 0) transpose_items((int)blockIdx.x, T_IN, T_ALL, G, KARG(6), KARG(14), WSP(bf16_t, WS_WIN), WSP(bf16_t, WS_WOUT), (float*)lds, tid);
      else if ((int)blockIdx.x >= nfull) transpose_items((int)blockIdx.x - nfull, T_IN, T_ALL, nidle, KARG(6), KARG(14), WSP(bf16_t, WS_WIN), WSP(bf16_t, WS_WOUT), (float*)lds, tid); }
    grid.sync();
    { const bf16_t* PROJ = WSP(bf16_t, WS_PROJ); float* out = KOUT;
      for (int u = blockIdx.x; u < 256; u += G) ssd_passA(u, PROJ, WSP(float, WS_DT), KARG(10), KARG(7), KARG(8), WSP(float, WS_S), WSP(float, WS_CDEC), WSP(bf16_t, WS_XTG), lds, tid, lane, wave);
      short_conv(PROJ, KARG(13), KARG(4), out, WSP(bf16_t, WS_YCAT), tid, G);
      for (int idx = blockIdx.x * 512 + tid; idx < 4 * 3 * 3072; idx += G * 512) { const int b = idx / 9216, r = (idx / 3072) % 3, ch = idx % 3072;
          out[O_CSP + idx] = bf2f(PROJ[(size_t)(b * 2048 + 2045 + r) * LDP + XB + ch]); } }
    xcd_barrier(xbar);
    state_scan(WSP(float, WS_S), WSP(float, WS_CDEC), WSP(bf16_t, WS_HPB), KOUT, tid, G);
    for (int u = blockIdx.x; u < 512; u += G) sample_unit(u, WSP(bf16_t, WS_PROJ), WSP(float, WS_DT), KARG(10), KARG(7), KARG(8), KARG(11), KARG(12), KARG(2), KARG(3), KOUT, WSP(bf16_t, WS_YCAT), lds, tid, lane, wave);
    xcd_barrier(xbar);
    for (int u = blockIdx.x; u < 256; u += G) ssd_passC(u, WSP(bf16_t, WS_PROJ), WSP(float, WS_DT), KARG(10), KARG(7), KARG(8), KARG(11), KARG(12), WSP(bf16_t, WS_XTG), WSP(bf16_t, WS_HPB), WSP(bf16_t, WS_YCAT), lds, tid, lane, wave);
    xcd_barrier(xbar);
    const bool fusedn = (G == 256);
    if (fusedn) { pg8::Gemm g{WSP(bf16_t, WS_YCAT), WSP(bf16_t, WS_WOUT), MP, DM, DMIX, DMIX}; pg8::StaticOrder So; So.init(MP, DM, G, (int)blockIdx.x);
      pg8::Epi2f E{KARG(0), KOUT, KARG(15), WSP(float, WS_SSQ), (unsigned*)(KWS + WS_CTL) + 4096, (LAS unsigned char*)lds};
      pg8::gemm_phase<pg8::Epi2f, pg8::StaticOrder>((LAS unsigned char*)lds, g, So, E); }
    else { pg8::Gemm g{WSP(bf16_t, WS_YCAT), WSP(bf16_t, WS_WOUT), MP, DM, DMIX, DMIX}; pg8::StaticOrder So; So.init(MP, DM, G, (int)blockIdx.x); pg8::Epi2 E{KARG(0), KOUT};
      pg8::gemm_phase<pg8::Epi2, pg8::StaticOrder>((LAS unsigned char*)lds, g, So, E); }
    for (int ks = (int)(blockIdx.x & 7); ks < 8; ks += 8) {
      pg8::Gemm g{WSP(bf16_t, WS_YCAT) + ks * 512, WSP(bf16_t, WS_WOUT) + ks * 512, MT, DM, 512, DMIX}; pg8::SplitOrder So{G, (int)blockIdx.x}; pg8::Epi2s E{WSP(bf16_t, WS_PART) + (size_t)ks * MS * DM};
      pg8::gemm_phase<pg8::Epi2s, pg8::SplitOrder>((LAS unsigned char*)lds, g, So, E); }
    xcd_barrier(xbar);
    { const int gw = blockIdx.x * 8 + wave, NGW = G * 8; const float* fnw = KARG(15); float* out = KOUT; const float* xsam = KARG(1); const bf16_t* part = WSP(bf16_t, WS_PART);
      f32x4 nv[8];
#define P4_LOAD(mm) do { if ((mm) < MP) { const f32x4* _o = (const f32x4*)(out + (size_t)(mm) * DM) + lane; _Pragma("unroll") for (int j = 0; j < 8; ++j) nv[j] = _o[64 * j]; } \
          else { const f32x4* _x = (const f32x4*)(xsam + (size_t)((mm) - MP) * DM) + lane; const u32x2* _p = (const u32x2*)(part + (size_t)((mm) - MP) * DM) + lane; \
              _Pragma("unroll") for (int j = 0; j < 8; ++j) nv[j] = _x[64 * j]; \
              _Pragma("unroll") for (int ks = 0; ks < 8; ++ks) _Pragma("unroll") for (int j = 0; j < 8; ++j) { const u32x2 _v = _p[(size_t)ks * (MS * DM / 4) + 64 * j]; \
                  nv[j] = nv[j] + (f32x4){bf_lo(_v.x), bf_hi(_v.x), bf_lo(_v.y), bf_hi(_v.y)}; } } } while (0)
      const int m0 = (fusedn ? MP : 0) + gw;
      if (m0 < MT) P4_LOAD(m0);
      for (int m = m0; m < MT; m += NGW) {
          f32x4 v[8]; float ss = 0.f;
#pragma unroll
          for (int j = 0; j < 8; ++j) { v[j] = nv[j]; ss += (v[j][0] * v[j][0] + v[j][1] * v[j][1]) + (v[j][2] * v[j][2] + v[j][3] * v[j][3]); }
          const int mn = m + NGW;
          if (mn < MT) P4_LOAD(mn);
          const float rs = rsqrtf(wave_sum(ss) * (1.f / DM) + EPS);
          f32x4* o = (f32x4*)(out + (size_t)m * DM) + lane;
#pragma unroll
          for (int j = 0; j < 8; ++j) { const f32x4 w = ((const f32x4*)fnw)[64 * j + lane]; o[64 * j] = v[j] * rs * w; }
      }
#undef P4_LOAD
    }
}

extern "C" void kernel_launch(void* const* d_in, const int* in_sizes, int n_in, void* d_out, int out_size, void* d_ws, size_t ws_size, hipStream_t stream) {
    static int grid = 0;
    if (grid == 0) {
        if (n_in != 16 || (size_t)out_size != O_END || ws_size < WS_END) { fprintf(stderr, "kernel_launch: unexpected shapes (n_in %d, out %d, ws %zu)\n", n_in, out_size, ws_size); grid = -1; return; }
        int dev = 0, cus = 0, per_cu = 0;
        hipGetDevice(&dev); hipDeviceGetAttribute(&cus, hipDeviceAttributeMultiprocessorCount, dev);
        hipFuncSetAttribute((const void*)hymba_fwd, hipFuncAttributeMaxDynamicSharedMemorySize, LDS_BYTES);
        hipOccupancyMaxActiveBlocksPerMultiprocessor(&per_cu, (const void*)hymba_fwd, 512, LDS_BYTES);
        if (per_cu < 1) { fprintf(stderr, "kernel_launch: occupancy query says %d blocks/CU\n", per_cu); per_cu = 1; }
        grid = cus * 1;
        (void)hipGetLastError();
    }
    if (grid < 0) return;
    if (hipMemsetAsync((char*)d_ws + WS_CTL, 0, 32768, stream) != hipSuccess) { fprintf(stderr, "kernel_launch: memset of the barrier words failed\n"); return; }
    Args a{};
    for (int i = 0; i < 16; ++i) a.in[i] = (const float*)d_in[i];
    a.out = (float*)d_out; a.ws = (unsigned char*)d_ws;
    void* args[] = {&a};
    hipError_t e = hipLaunchCooperativeKernel((const void*)hymba_fwd, dim3(grid), dim3(512), args, LDS_BYTES, stream);
    if (e != hipSuccess) fprintf(stderr, "cooperative launch failed: %s (grid %d)\n", hipGetErrorString(e), grid);
}
```
